# Optimizing an MI355X kernel written in HIP

```python
import math
import jax
import jax.numpy as jnp
from jax import lax
import numpy as np

D_MODEL = 2048
BATCH = 1
SEQ = 8192
DEPTH = 1

CHUNK = 64
SB_HEAD_DIM = 64
SB_WIDTH = D_MODEL // 2
SB_HEADS = SB_WIDTH // SB_HEAD_DIM
SB_BLOCK = 128
SSM_HEAD_DIM = 64
SSM_INNER = D_MODEL - SB_WIDTH
SSM_HEADS = SSM_INNER // SSM_HEAD_DIM
SSM_GROUPS = 2
SSM_STATE = 128
SSM_CONV = 4
SSM_CONV_DIM = SSM_INNER + 2 * SSM_GROUPS * SSM_STATE
MIX_WIDTH = SB_WIDTH + SSM_INNER
IN_PROJ = 3 * SB_WIDTH + SSM_INNER + SSM_CONV_DIM + SSM_HEADS
IN_SPLITS = (SB_WIDTH, 2 * SB_WIDTH, 3 * SB_WIDTH, 3 * SB_WIDTH + SSM_INNER,
             3 * SB_WIDTH + SSM_INNER + SSM_CONV_DIM)
N_EXPERTS = 32
TOP_K = 4
D_FF = D_MODEL
SWIGLU_LIMIT = 7.0
SWIGLU_ALPHA = 1.702
MOE_BLOCK = 128
RMS_EPS = 1e-5

kernel_name = "hymba_stickbreak_ssd_moe_block"


def rmsnorm(x, g):
    xf = x.astype(jnp.float32)
    y = xf * lax.rsqrt(jnp.mean(xf * xf, axis=-1, keepdims=True) + RMS_EPS)
    return (y * g.astype(jnp.float32)).astype(x.dtype)


def stick_breaking_attention(q, k, v):
    b, s, h, dh = q.shape
    nb = s // SB_BLOCK
    f32 = jnp.float32
    kf = k.astype(f32)
    vf = v.astype(f32)
    q_blocks = jnp.moveaxis(q.astype(f32).reshape(b, nb, SB_BLOCK, h, dh), 1, 0)
    key_pos = jnp.arange(s)
    scale = dh ** -0.5

    def one_block(args):
        q_blk, blk = args
        q_pos = blk * SB_BLOCK + jnp.arange(SB_BLOCK)
        past = key_pos[None, :] < q_pos[:, None]
        logits = jnp.einsum('bqhd,bkhd->bhqk', q_blk, kf) * scale
        log_keep = jnp.where(past, jax.nn.log_sigmoid(-logits), 0.0)
        between = lax.cumsum(log_keep, axis=3, reverse=True) - log_keep
        weights = jnp.where(past, jnp.exp(jax.nn.log_sigmoid(logits) + between), 0.0)
        return jnp.einsum('bhqk,bkhd->bqhd', weights, vf)

    out = lax.map(one_block, (q_blocks, jnp.arange(nb)))
    return jnp.moveaxis(out, 0, 1).reshape(b, s, h, dh)


def causal_depthwise_conv(x, w, bias):
    kw = w.shape[0]
    y = lax.conv_general_dilated(
        x, w[:, None, :].astype(x.dtype), window_strides=(1,), padding=[(kw - 1, 0)],
        dimension_numbers=('NWC', 'WIO', 'NWC'), feature_group_count=x.shape[-1])
    return y + bias.astype(x.dtype)


def segsum(a):
    t = a.shape[-1]
    a_rep = jnp.broadcast_to(a[..., None], a.shape + (t,))
    a_rep = jnp.where(jnp.tril(jnp.ones((t, t), bool), -1), a_rep, 0.0)
    seg = jnp.cumsum(a_rep, axis=-2)
    return jnp.where(jnp.tril(jnp.ones((t, t), bool), 0), seg, -jnp.inf)


def ssd_chunked(xs, a_dt, bmat, cmat):
    b, s, h, p = xs.shape
    g, n = bmat.shape[2], bmat.shape[3]
    r = h // g
    c = s // CHUNK
    x_c = xs.reshape(b, c, CHUNK, g, r, p)
    a_c = a_dt.reshape(b, c, CHUNK, g, r).transpose(0, 3, 4, 1, 2)
    b_c = bmat.reshape(b, c, CHUNK, g, n)
    c_c = cmat.reshape(b, c, CHUNK, g, n)
    a_cum = jnp.cumsum(a_c, axis=-1)
    decay_in = jnp.exp(segsum(a_c))
    cb = jnp.einsum('bclgn,bcsgn->bgcls', c_c, b_c)
    y_diag = jnp.einsum('bgrcls,bcsgrp->bclgrp', cb[:, :, None] * decay_in, x_c)
    decay_states = jnp.exp(a_cum[..., -1:] - a_cum)
    states = jnp.einsum('bclgn,bgrcl,bclgrp->cbgrpn', b_c, decay_states, x_c)
    chunk_decay = jnp.exp(a_cum[..., -1]).transpose(3, 0, 1, 2)

    def step(carry, inp):
        st, dec = inp
        return carry * dec[..., None, None] + st, carry

    init = jnp.zeros(states.shape[1:], states.dtype)
    _, prev_states = lax.scan(step, init, (states, chunk_decay))
    y_off = jnp.einsum('bclgn,cbgrpn,bgrcl->bclgrp', c_c, prev_states, jnp.exp(a_cum))
    return (y_diag + y_off).reshape(b, s, h, p)


def mamba2_mixer(z, xbc, dt, conv_w, conv_b, dt_bias, a_log, d_skip, g_ssm):
    b, s, _ = xbc.shape
    f32 = jnp.float32
    xbc = jax.nn.silu(causal_depthwise_conv(xbc, conv_w, conv_b)).astype(f32)
    xs, bmat, cmat = jnp.split(xbc, (SSM_INNER, SSM_INNER + SSM_GROUPS * SSM_STATE), axis=-1)
    xs = xs.reshape(b, s, SSM_HEADS, SSM_HEAD_DIM)
    bmat = bmat.reshape(b, s, SSM_GROUPS, SSM_STATE)
    cmat = cmat.reshape(b, s, SSM_GROUPS, SSM_STATE)
    dt = jax.nn.softplus(dt.astype(f32) + dt_bias.astype(f32))
    a = -jnp.exp(a_log.astype(f32))
    y = ssd_chunked(xs * dt[..., None], dt * a, bmat, cmat)
    y = y + d_skip.astype(f32)[:, None] * xs
    y = y.reshape(b, s, SSM_INNER) * jax.nn.silu(z.astype(f32))
    y = y.reshape(b, s, SSM_GROUPS, SSM_INNER // SSM_GROUPS)
    y = y * lax.rsqrt(jnp.mean(y * y, axis=-1, keepdims=True) + RMS_EPS)
    return y.reshape(b, s, SSM_INNER) * g_ssm.astype(f32)


def moe_ffn(h, w_router, b_router, w_gate_up, b_gate_up, w_down, b_down):
    b, s, d = h.shape
    t = b * s
    f32 = jnp.float32
    hf = h.reshape(t, d)
    logits = (hf @ w_router).astype(f32) + b_router.astype(f32)
    top_vals, top_idx = lax.top_k(logits, TOP_K)
    gates = jax.nn.softmax(top_vals, axis=-1)
    flat_e = top_idx.reshape(-1)
    order = jnp.argsort(flat_e, stable=True)
    sorted_e = flat_e[order]
    sorted_tok = (order // TOP_K).astype(jnp.int32)
    sorted_gate = gates.reshape(-1)[order]
    counts = jnp.bincount(flat_e, length=N_EXPERTS)
    padded = (counts + MOE_BLOCK - 1) // MOE_BLOCK * MOE_BLOCK
    start = jnp.cumsum(counts) - counts
    pend = jnp.cumsum(padded)
    pstart = pend - padded
    dest = pstart[sorted_e] + (jnp.arange(t * TOP_K) - start[sorted_e])
    n_blocks = -(-(t * TOP_K) // MOE_BLOCK) + N_EXPERTS
    n_slots = n_blocks * MOE_BLOCK
    slot_tok = jnp.zeros((n_slots,), jnp.int32).at[dest].set(sorted_tok)
    slot_gate = jnp.zeros((n_slots,), f32).at[dest].set(sorted_gate)
    block_e = jnp.minimum(
        jnp.searchsorted(pend, jnp.arange(n_blocks) * MOE_BLOCK, side='right'), N_EXPERTS - 1)
    xs = hf[slot_tok].reshape(n_blocks, MOE_BLOCK, d)

    def expert_block(args):
        xb, e = args
        gu = (xb @ w_gate_up[e] + b_gate_up[e]).astype(f32)
        gate = jnp.minimum(gu[:, 0::2], SWIGLU_LIMIT)
        up = jnp.clip(gu[:, 1::2], -SWIGLU_LIMIT, SWIGLU_LIMIT)
        act = gate * jax.nn.sigmoid(SWIGLU_ALPHA * gate) * (up + 1.0)
        return (act.astype(xb.dtype) @ w_down[e] + b_down[e]).astype(f32)

    ys = lax.map(expert_block, (xs, block_e)).reshape(n_slots, d)
    out = jnp.zeros((t, d), f32).at[slot_tok].add(ys * slot_gate[:, None])
    return out.reshape(b, s, d).astype(h.dtype)


def setup_inputs(seed: int = 0) -> dict:
    key = jax.random.key(seed)
    ks = jax.random.split(key, 18)
    f32 = jnp.float32

    def nrm(k, shape, scale):
        return jax.random.normal(k, shape, f32) * scale

    x = nrm(ks[0], (BATCH, SEQ, D_MODEL), 1.0)
    g_mix = 1.0 + nrm(ks[1], (DEPTH, D_MODEL), 0.02)
    w_in = nrm(ks[2], (DEPTH, D_MODEL, IN_PROJ), D_MODEL ** -0.5)
    conv_w = nrm(ks[3], (DEPTH, SSM_CONV, SSM_CONV_DIM), SSM_CONV ** -0.5)
    conv_b = nrm(ks[4], (DEPTH, SSM_CONV_DIM), 0.01)
    dt0 = jnp.exp(jax.random.uniform(ks[5], (DEPTH, SSM_HEADS), f32,
                                     math.log(1e-3), math.log(1e-1)))
    dt_bias = dt0 + jnp.log(-jnp.expm1(-dt0))
    a_log = jnp.log(jax.random.uniform(ks[6], (DEPTH, SSM_HEADS), f32, 1.0, 16.0))
    d_skip = 1.0 + nrm(ks[7], (DEPTH, SSM_HEADS), 0.1)
    g_ssm = 1.0 + nrm(ks[8], (DEPTH, SSM_INNER), 0.02)
    w_out = nrm(ks[9], (DEPTH, MIX_WIDTH, D_MODEL), MIX_WIDTH ** -0.5)
    g_ffn = 1.0 + nrm(ks[10], (DEPTH, D_MODEL), 0.02)
    w_router = nrm(ks[11], (DEPTH, D_MODEL, N_EXPERTS), D_MODEL ** -0.5)
    b_router = nrm(ks[12], (DEPTH, N_EXPERTS), 0.01)
    w_gate_up = nrm(ks[13], (DEPTH, N_EXPERTS, D_MODEL, 2 * D_FF), D_MODEL ** -0.5)
    b_gate_up = nrm(ks[14], (DEPTH, N_EXPERTS, 2 * D_FF), 0.01)
    w_down = nrm(ks[15], (DEPTH, N_EXPERTS, D_FF, D_MODEL), D_FF ** -0.5)
    b_down = nrm(ks[16], (DEPTH, N_EXPERTS, D_MODEL), 0.01)
    g_final = 1.0 + nrm(ks[17], (D_MODEL,), 0.02)
    return {"x": x, "g_mix": g_mix, "w_in": w_in, "conv_w": conv_w, "conv_b": conv_b,
            "dt_bias": dt_bias, "a_log": a_log, "d_skip": d_skip, "g_ssm": g_ssm,
            "w_out": w_out, "g_ffn": g_ffn, "w_router": w_router, "b_router": b_router,
            "w_gate_up": w_gate_up, "b_gate_up": b_gate_up, "w_down": w_down,
            "b_down": b_down, "g_final": g_final}


def reference(x, g_mix, w_in, conv_w, conv_b, dt_bias, a_log, d_skip, g_ssm, w_out,
              g_ffn, w_router, b_router, w_gate_up, b_gate_up, w_down, b_down, g_final):
    b, s, _ = x.shape
    for l in range(DEPTH):
        h = rmsnorm(x, g_mix[l])
        proj = h @ w_in[l]
        q, k, v, z, xbc, dt = jnp.split(proj, IN_SPLITS, axis=-1)
        heads = (b, s, SB_HEADS, SB_HEAD_DIM)
        attn = stick_breaking_attention(q.reshape(heads), k.reshape(heads), v.reshape(heads))
        attn = attn.reshape(b, s, SB_WIDTH).astype(x.dtype)
        ssm = mamba2_mixer(z, xbc, dt, conv_w[l], conv_b[l], dt_bias[l], a_log[l],
                           d_skip[l], g_ssm[l]).astype(x.dtype)
        x = x + jnp.concatenate([attn, ssm], axis=-1) @ w_out[l]
        x = x + moe_ffn(rmsnorm(x, g_ffn[l]), w_router[l], b_router[l], w_gate_up[l],
                        b_gate_up[l], w_down[l], b_down[l])
    return rmsnorm(x, g_final)
```

```cpp
#include <hip/hip_runtime.h>
#include <cstdio>
#include <cstdint>
#include <cstring>

#ifndef MK_SPLIT
#define MK_SPLIT 0
#endif

#define LAS __attribute__((address_space(3)))
#define GAS __attribute__((address_space(1)))
typedef unsigned short bf16_t;
typedef short bf16x8 __attribute__((ext_vector_type(8)));
typedef float f32x4 __attribute__((ext_vector_type(4)));
typedef float f32x2 __attribute__((ext_vector_type(2)));
typedef unsigned u32x4 __attribute__((ext_vector_type(4)));
typedef unsigned u32x2 __attribute__((ext_vector_type(2)));

constexpr int S = 8192, D = 2048, H = 16, HD = 64, NE = 32, DFF = 2048;
constexpr int NPJ = 5632;
constexpr int NPAD = 5888;
constexpr int NPROJ = 5648;
constexpr int C_K = 1024, C_V = 2048, C_Z = 3072, C_XBC = 4096;
constexpr int XBC = 1536, NST = 128;
constexpr float EPS = 1e-5f;
constexpr int ECAP = 8192;
constexpr int MAXROWS = S * 4 + NE * 256;

constexpr size_t MiB = 1u << 20;
constexpr size_t WS_CTL = 0, CTL_ZERO_BYTES = 1 * MiB;
constexpr size_t WS_WIN = 2 * MiB;
constexpr size_t WS_WOUT = WS_WIN + (size_t)NPAD * D * 2;
constexpr size_t WS_WGU = WS_WOUT + (size_t)D * D * 2;
constexpr size_t WS_WDN = WS_WGU + (size_t)NE * 2 * DFF * D * 2;
constexpr size_t WS_XN = WS_WDN + (size_t)NE * D * DFF * 2;
constexpr size_t WS_PROJ = WS_XN + (size_t)S * D * 2;
constexpr size_t WS_DT = WS_PROJ + (size_t)S * NPJ * 2;
constexpr size_t WS_DTS = WS_DT + (size_t)S * H * 4;
constexpr size_t WS_XBC = WS_DTS + (size_t)S * H * 4;
constexpr size_t WS_YRAW = WS_XBC + (size_t)S * XBC * 4;
constexpr size_t WS_MIX = WS_YRAW + (size_t)S * 1024 * 4;
constexpr size_t WS_X2 = WS_MIX + (size_t)S * D * 2;
constexpr size_t WS_H2 = WS_X2 + (size_t)S * D * 4;
constexpr size_t WS_TOKOF = WS_H2 + (size_t)S * D * 2;
constexpr size_t WS_TE = WS_TOKOF + (size_t)NE * ECAP * 4;
constexpr size_t WS_TP = WS_TE + (size_t)S * 4 * 4;
constexpr size_t WS_TG = WS_TP + (size_t)S * 4 * 4;
constexpr size_t WS_ACT = WS_TG + (size_t)S * 4 * 4;
constexpr size_t WS_YS = WS_ACT + (size_t)MAXROWS * DFF * 2;
constexpr size_t WS_END = WS_YS + (size_t)MAXROWS * D * 2;
constexpr int CW_BAR = 4096;
constexpr int CW_CNT = 8192;
constexpr int CW_ATTQ = 8448;

constexpr int RING_BYTES = 131072;
constexpr int LDSCTL_OFF = RING_BYTES;
constexpr int L_MISC = 0;
constexpr int L_CNT = 64, L_PFXU = 128, L_POFF = 192;
constexpr int LDS_BYTES = 147456;
constexpr int NWAVES = 8, NT = 512;

#define LDS_WAIT() asm volatile("s_waitcnt lgkmcnt(0)" ::: "memory")
#define VM_WAIT() asm volatile("s_waitcnt vmcnt(0)" ::: "memory")
#define RLX_AGENT __ATOMIC_RELAXED, __HIP_MEMORY_SCOPE_AGENT
__device__ __forceinline__ unsigned cvt_pk_bf16(float lo, float hi) { unsigned r; asm volatile("v_cvt_pk_bf16_f32 %0, %1, %2" : "=v"(r) : "v"(lo), "v"(hi)); return r; }
__device__ __forceinline__ float bf_lo(unsigned u) { return __builtin_bit_cast(float, u << 16); }
__device__ __forceinline__ float bf_hi(unsigned u) { return __builtin_bit_cast(float, u & 0xffff0000u); }
__device__ __forceinline__ float wave_sum(float v) {
#pragma unroll
    for (int o = 1; o < 64; o <<= 1) v += __shfl_xor(v, o);
    return v;
}
__device__ __forceinline__ float softplus_acc(float x) { return fmaxf(x, 0.f) + log1pf(expf(-fabsf(x))); }
__device__ __forceinline__ float silu_acc(float x) { return x / (1.f + expf(-x)); }

#define XB_TMO      128
#define XB_XCNT(j)  (256  + 64 * (j))
#define XB_XSUB(j)  (1280 + 64 * (j))
#define XB_XGEN(j)  (2304 + 64 * (j))
#define XB_TOP      3328
#define XB_TOPGEN   3392
#define XCD_BAR_WORDS 3456
#define XB_SPIN_CAP (1u << 18)
__device__ __forceinline__ unsigned xb_ld(unsigned* p)              { return __hip_atomic_load(p, __ATOMIC_RELAXED, __HIP_MEMORY_SCOPE_AGENT); }
__device__ __forceinline__ unsigned xb_add(unsigned* p, unsigned v) { return __hip_atomic_fetch_add(p, v, __ATOMIC_RELAXED, __HIP_MEMORY_SCOPE_AGENT); }
__device__ __forceinline__ unsigned xb_xcc_id() { return (unsigned)__builtin_amdgcn_s_getreg((3 << 11) | 20) & 0xFu; }
#define XB_SPIN(cond, bar) do { unsigned _sp = 0; while (cond) { __builtin_amdgcn_s_sleep(1); \
    if ((++_sp & 255u) == 0u) { if (xb_ld(&(bar)[XB_TMO])) break; if (_sp > XB_SPIN_CAP) { atomicAdd(&(bar)[XB_TMO], 1u); break; } } } } while (0)
struct XcdBarrier { unsigned* bar; unsigned x; volatile LAS unsigned* st; };
__device__ __forceinline__ XcdBarrier xcd_barrier_post(unsigned* bar, volatile LAS unsigned* st) {
    XcdBarrier b; b.bar = bar; b.x = xb_xcc_id(); b.st = st;
    if (threadIdx.x == 0) (void)xb_add(&bar[XB_XCNT(b.x)], 1u);
    return b;
}
__device__ __forceinline__ void xcd_barrier_complete(unsigned* bar, unsigned x, unsigned& nloc, unsigned& nx) {
    const unsigned G = gridDim.x * gridDim.y * gridDim.z;
    unsigned sum, cnt, mine, sp = 0u;
    for (;;) {
        sum = 0u; cnt = 0u; mine = 0u;
#pragma unroll
        for (unsigned j = 0; j < 16; ++j) { const unsigned c = xb_ld(&bar[XB_XCNT(j)]); sum += c; cnt += (c > 0u) ? 1u : 0u; mine = (j == x) ? c : mine; }
        if (sum == G) break;
        __builtin_amdgcn_s_sleep(1);
        if ((++sp & 255u) == 0u) { if (xb_ld(&bar[XB_TMO])) break; if (sp > XB_SPIN_CAP) { atomicAdd(&bar[XB_TMO], 1u); break; } }
    }
    nloc = mine > 0u ? mine : 1u; nx = cnt > 0u ? cnt : 1u;
}
__device__ __forceinline__ void xcd_barrier(const XcdBarrier& b) {
    asm volatile("s_waitcnt vmcnt(0)" ::: "memory");
    __syncthreads();
    if (threadIdx.x == 0) {
        unsigned* bar = b.bar;
        __builtin_amdgcn_s_waitcnt(0);
        unsigned nloc = b.st[0], nx = b.st[1];
        if (nloc == 0u) { xcd_barrier_complete(bar, b.x, nloc, nx); b.st[0] = nloc; b.st[1] = nx; }
        const unsigned old = xb_add(&bar[XB_XSUB(b.x)], 1u);
        const unsigned gen = old / nloc;
        if (old + 1u == (gen + 1u) * nloc) {
            __builtin_amdgcn_fence(__ATOMIC_RELEASE, "agent");
            asm volatile("s_waitcnt vmcnt(0)" ::: "memory");
            const unsigned og = xb_add(&bar[XB_TOP], 1u);
            const unsigned tg = og / nx;
            if (og + 1u == (tg + 1u) * nx) xb_add(&bar[XB_TOPGEN], 1u);
            else XB_SPIN(xb_ld(&bar[XB_TOPGEN]) == tg, bar);
            __builtin_amdgcn_fence(__ATOMIC_ACQUIRE, "agent");
            xb_add(&bar[XB_XGEN(b.x)], 1u);
            asm volatile("s_waitcnt vmcnt(0)" ::: "memory");
        } else {
            XB_SPIN(xb_ld(&bar[XB_XGEN(b.x)]) == gen, bar);
            __builtin_amdgcn_fence(__ATOMIC_ACQUIRE, "agent");
            asm volatile("s_waitcnt vmcnt(0)" ::: "memory");
        }
    }
    __syncthreads();
}

namespace pg8 {
constexpr int BM = 256, BK = 64, HALF = 128, HTB = HALF * BK * 2, NXCD = 8, WGM = 8, K = 2048, NTK = K / BK;
constexpr unsigned HSTEP = (unsigned)HALF * K * 2;
constexpr size_t TSTEP = 2 * (size_t)HSTEP;
__host__ __device__ __forceinline__ int lds_byte(int r, int c) { const int st = (r >> 4) * 2 + (c >> 5), rr = r & 15, cc = c & 31, ob = rr * 64 + cc * 2; return st * 1024 + (ob ^ (((ob >> 9) & 1) << 5)); }
__host__ __device__ __forceinline__ void stage_rc(int b, int& R, int& C) { const int st = b / 1024, sb = b % 1024, swz = sb ^ (((sb >> 9) & 1) << 5); R = (st >> 1) * 16 + swz / 64; C = (st & 1) * 32 + (swz % 64) / 2; }
__host__ __device__ __forceinline__ int perm32(int rho) { const int n = rho >> 4, i = rho & 15; return 8 * (i >> 2) + 4 * n + (i & 3); }
struct Unit { int pm, pn, e; };

struct NatOrder {
    const char* A; const char* Bt; int nM, nN, nwg, G, c;
    __device__ void init(const void* A_, const void* Bt_, int M, int N, int G_, int c_) { A = (const char*)A_; Bt = (const char*)Bt_; nM = M / BM; nN = N / BM; nwg = nM * nN; G = G_; c = c_; }
    __device__ __forceinline__ bool next(int i, Unit& u) const {
        const long L = (long)i * G + c; if (L >= nwg) return false;
        int wgid = (int)L; { const int q = nwg / NXCD, r = nwg % NXCD, xcd = wgid % NXCD, off = wgid / NXCD; wgid = (xcd < r ? xcd * (q + 1) : r * (q + 1) + (xcd - r) * q) + off; }
        const int nig = WGM * nN, gid = wgid / nig, fm = gid * WGM, gsz = (nM - fm) < WGM ? (nM - fm) : WGM;
        u.pm = fm + ((wgid % nig) % gsz); u.pn = (wgid % nig) / gsz; u.e = 0; return true;
    }
    __device__ __forceinline__ const char* a_base(const Unit& u) const { return A + (size_t)u.pm * TSTEP; }
    __device__ __forceinline__ const char* b_base(const Unit& u) const { return Bt + (size_t)u.pn * TSTEP; }
    __device__ __forceinline__ void a_offs(const Unit&, const unsigned (&nat)[2], unsigned (&v)[4]) const { v[0] = nat[0]; v[1] = nat[1]; v[2] = nat[0] + HSTEP; v[3] = nat[1] + HSTEP; }
};
template <bool GATHER> struct MoeOrder {
    const char* A; const char* Bt; const int* tokof; const LAS int* cnt; const LAS int* pfxU; const LAS int* poff; int ntn, G, c;
    __device__ __forceinline__ bool next(int i, Unit& u) const {
        const int L = i * G + c; if (L >= pfxU[NE]) return false;
        int e = 0;
#pragma unroll 1
        for (; e < NE - 1; ++e) if (L < pfxU[e + 1]) break;
        const int r = L - pfxU[e], mt = (cnt[e] + 255) >> 8;
        u.e = e; u.pn = r / mt; u.pm = r - u.pn * mt; return true;
    }
    __device__ __forceinline__ const char* a_base(const Unit& u) const { return GATHER ? A : A + ((size_t)poff[u.e] + (size_t)u.pm * BM) * (K * 2); }
    __device__ __forceinline__ const char* b_base(const Unit& u) const { return Bt + ((size_t)u.e * ntn + u.pn) * TSTEP; }
    __device__ __forceinline__ void a_offs(const Unit& u, const unsigned (&nat)[2], unsigned (&v)[4]) const {
        if (!GATHER) { v[0] = nat[0]; v[1] = nat[1]; v[2] = nat[0] + HSTEP; v[3] = nat[1] + HSTEP; return; }
        const int n = cnt[u.e];
#pragma unroll
        for (int h = 0; h < 2; ++h)
#pragma unroll
            for (int i = 0; i < 2; ++i) { const unsigned R = nat[i] / (K * 2), Cb = nat[i] % (K * 2); int pos = u.pm * BM + h * HALF + (int)R; pos = pos < n ? pos : n - 1;
                const int tok = tokof[u.e * ECAP + pos]; v[h * 2 + i] = (unsigned)tok * (K * 2) + Cb; }
    }
};

struct EpiProj {
    static constexpr bool PERM = true;
    bf16_t* P; float* DT;
    __device__ __forceinline__ void operator()(const f32x4 (&acc)[2][2][4][2], const Unit& u, int wr, int wc, int fr, int fq) const {
        const int row0 = u.pm * BM + wr * 64 + fr, col0 = u.pn * BM + wc * 32 + 8 * fq;
        if (u.pn < 22) {
#pragma unroll
            for (int ai = 0; ai < 2; ++ai)
#pragma unroll
                for (int m = 0; m < 4; ++m) { bf16_t* rowp = P + (size_t)(row0 + ai * HALF + m * 16) * NPJ + col0;
#pragma unroll
                    for (int bj = 0; bj < 2; ++bj) { const f32x4 v0 = acc[ai][bj][m][0], v1 = acc[ai][bj][m][1];
                        u32x4 w; w.x = cvt_pk_bf16(v0[0], v0[1]); w.y = cvt_pk_bf16(v0[2], v0[3]); w.z = cvt_pk_bf16(v1[0], v1[1]); w.w = cvt_pk_bf16(v1[2], v1[3]);
                        *(u32x4*)(rowp + bj * HALF) = w; } }
        } else if (wc == 0 && fq < 2) {
#pragma unroll
            for (int ai = 0; ai < 2; ++ai)
#pragma unroll
                for (int m = 0; m < 4; ++m) { float* rowp = DT + (size_t)(row0 + ai * HALF + m * 16) * H + 8 * fq;
                    *(f32x4*)(rowp) = acc[ai][0][m][0]; *(f32x4*)(rowp + 4) = acc[ai][0][m][1]; }
        }
    }
};
struct EpiRes {
    static constexpr bool PERM = false;
    const float* X; float* O;
    __device__ __forceinline__ void operator()(const f32x4 (&acc)[2][2][4][2], const Unit& u, int wr, int wc, int fr, int fq) const {
        const int row0 = u.pm * BM + wr * 64 + fr, col0 = u.pn * BM + wc * 32 + 4 * fq;
#pragma unroll
        for (int ai = 0; ai < 2; ++ai)
#pragma unroll
            for (int m = 0; m < 4; ++m) { const size_t ro = (size_t)(row0 + ai * HALF + m * 16) * D + col0;
#pragma unroll
                for (int bj = 0; bj < 2; ++bj)
#pragma unroll
                    for (int n = 0; n < 2; ++n) { const f32x4 xv = *(const f32x4*)(X + ro + bj * HALF + n * 16); *(f32x4*)(O + ro + bj * HALF + n * 16) = acc[ai][bj][m][n] + xv; } }
    }
};
struct EpiGU {
    static constexpr bool PERM = true;
    bf16_t* ACT; const float* bias; const LAS int* poff;
    __device__ __forceinline__ float act1(float g, float up) const { g = fminf(g, 7.f); up = fminf(fmaxf(up, -7.f), 7.f); return g * (1.f / (1.f + __expf(-1.702f * g))) * (up + 1.f); }
    __device__ __forceinline__ void operator()(const f32x4 (&acc)[2][2][4][2], const Unit& u, int wr, int wc, int fr, int fq) const {
        const int row0 = poff[u.e] + u.pm * BM + wr * 64 + fr, col0 = u.pn * BM + wc * 32 + 8 * fq;
        const float* bp = bias + (size_t)u.e * (2 * DFF) + col0;
        f32x4 bv[2][2];
#pragma unroll
        for (int bj = 0; bj < 2; ++bj)
#pragma unroll
            for (int n = 0; n < 2; ++n) bv[bj][n] = *(const f32x4*)(bp + bj * HALF + 4 * n);
#pragma unroll
        for (int ai = 0; ai < 2; ++ai)
#pragma unroll
            for (int m = 0; m < 4; ++m) { bf16_t* rowp = ACT + (size_t)(row0 + ai * HALF + m * 16) * DFF + (col0 >> 1);
#pragma unroll
                for (int bj = 0; bj < 2; ++bj) { const f32x4 v0 = acc[ai][bj][m][0] + bv[bj][0], v1 = acc[ai][bj][m][1] + bv[bj][1];
                    u32x2 w; w.x = cvt_pk_bf16(act1(v0[0], v0[1]), act1(v0[2], v0[3])); w.y = cvt_pk_bf16(act1(v1[0], v1[1]), act1(v1[2], v1[3]));
                    *(u32x2*)(rowp + bj * (HALF / 2)) = w; } }
    }
};
struct EpiDown {
    static constexpr bool PERM = true;
    bf16_t* YS; const float* bias; const LAS int* poff;
    __device__ __forceinline__ void operator()(const f32x4 (&acc)[2][2][4][2], const Unit& u, int wr, int wc, int fr, int fq) const {
        const int row0 = poff[u.e] + u.pm * BM + wr * 64 + fr, col0 = u.pn * BM + wc * 32 + 8 * fq;
        const float* bp = bias + (size_t)u.e * D + col0;
        f32x4 bv[2][2];
#pragma unroll
        for (int bj = 0; bj < 2; ++bj)
#pragma unroll
            for (int n = 0; n < 2; ++n) bv[bj][n] = *(const f32x4*)(bp + bj * HALF + 4 * n);
#pragma unroll
        for (int ai = 0; ai < 2; ++ai)
#pragma unroll
            for (int m = 0; m < 4; ++m) { bf16_t* rowp = YS + (size_t)(row0 + ai * HALF + m * 16) * D + col0;
#pragma unroll
                for (int bj = 0; bj < 2; ++bj) { const f32x4 v0 = acc[ai][bj][m][0] + bv[bj][0], v1 = acc[ai][bj][m][1] + bv[bj][1];
                    u32x4 w; w.x = cvt_pk_bf16(v0[0], v0[1]); w.y = cvt_pk_bf16(v0[2], v0[3]); w.z = cvt_pk_bf16(v1[0], v1[1]); w.w = cvt_pk_bf16(v1[2], v1[3]);
                    *(u32x4*)(rowp + bj * HALF) = w; } }
    }
};

template <class Epi, class Sched>
__device__ __forceinline__ void gemm_phase(LAS unsigned char* lds, const Sched& S, const Epi& E) {
    const int tid = threadIdx.x, wid = __builtin_amdgcn_readfirstlane(tid >> 6), lane = tid & 63, wr = wid >> 2, wc = wid & 3, fr = lane & 15, fq = lane >> 4;
    unsigned natA[2], voffB[2];
#pragma unroll
    for (int i = 0; i < 2; ++i) { int R, C; stage_rc(tid * 16 + i * 8192, R, C); const int Rb = Epi::PERM ? ((R & ~31) + perm32(R & 31)) : R;
        natA[i] = (unsigned)(R * K + C) * 2u; voffB[i] = (unsigned)(Rb * K + C) * 2u; }
    const size_t kstep = (size_t)(BK * 2);
    const unsigned ldsw = (unsigned)wid * 1024u;
    const int aoff = lds_byte(wr * 64 + fr, fq * 8), boff = lds_byte(wc * 32 + fr, fq * 8);
#define PG8_SA(b, h) (((b) * 2 + (h)) * HTB)
#define PG8_SB(b, h) ((4 + (b) * 2 + (h)) * HTB)
#define PG8_STAGE_A(bufoff, gbase, h) do { _Pragma("unroll") for (int _i = 0; _i < 2; ++_i) \
        __builtin_amdgcn_global_load_lds((const unsigned*)((const char*)(gbase) + va[(h) * 2 + _i]), (LAS unsigned*)(lds + (bufoff) + ldsw + _i * 8192), 16, 0, 0); } while (0)
#define PG8_STAGE_B(bufoff, gbase) do { _Pragma("unroll") for (int _i = 0; _i < 2; ++_i) \
        __builtin_amdgcn_global_load_lds((const unsigned*)((const char*)(gbase) + voffB[_i]), (LAS unsigned*)(lds + (bufoff) + ldsw + _i * 8192), 16, 0, 0); } while (0)
#define PG8_LDA(dst, b, h) do { _Pragma("unroll") for (int m = 0; m < 4; ++m) _Pragma("unroll") for (int k = 0; k < 2; ++k) dst[m][k] = *(const LAS bf16x8*)(lds + PG8_SA(b, h) + aoff + m * 2048 + k * 1024); } while (0)
#define PG8_LDB(dst, b, h) do { _Pragma("unroll") for (int n = 0; n < 2; ++n) _Pragma("unroll") for (int k = 0; k < 2; ++k) dst[n][k] = *(const LAS bf16x8*)(lds + PG8_SB(b, h) + boff + n * 2048 + k * 1024); } while (0)
#define PG8_MMA(ai, bj, At, Bt) do { __builtin_amdgcn_s_setprio(1); _Pragma("unroll") for (int m = 0; m < 4; ++m) _Pragma("unroll") for (int n = 0; n < 2; ++n) _Pragma("unroll") for (int k = 0; k < 2; ++k) \
        acc[ai][bj][m][n] = __builtin_amdgcn_mfma_f32_16x16x32_bf16(Bt[n][k], At[m][k], acc[ai][bj][m][n], 0, 0, 0); __builtin_amdgcn_s_setprio(0); } while (0)
#define PG8_WAIT_V(n) asm volatile("s_waitcnt vmcnt(" #n ")" ::: "memory")
#define PG8_WAIT_L(n) asm volatile("s_waitcnt lgkmcnt(" #n ")" ::: "memory")
#define PG8_BAR __builtin_amdgcn_s_barrier()
#define PG8_SCHED __builtin_amdgcn_sched_barrier(0)
    Unit cur, nxt; int ui = 0;
    if (!S.next(0, cur)) return;
    f32x4 acc[2][2][4][2];
#pragma unroll
    for (int a = 0; a < 2; ++a)
#pragma unroll
        for (int b = 0; b < 2; ++b)
#pragma unroll
            for (int m = 0; m < 4; ++m)
#pragma unroll
                for (int n = 0; n < 2; ++n) acc[a][b][m][n] = (f32x4){0.f, 0.f, 0.f, 0.f};
    bf16x8 At[4][2], B0[2][2], B1[2][2];
    unsigned va[4]; S.a_offs(cur, natA, va);
    const char* cA = S.a_base(cur); const char* cB = S.b_base(cur);
    PG8_STAGE_B(PG8_SB(0, 0), cB); PG8_STAGE_B(PG8_SB(0, 1), cB + HSTEP); PG8_STAGE_A(PG8_SA(0, 0), cA, 0); PG8_STAGE_A(PG8_SA(0, 1), cA, 1);
    if (wr == 1) PG8_BAR;
    PG8_WAIT_V(2); PG8_BAR;
    PG8_STAGE_B(PG8_SB(1, 0), cB + kstep); PG8_STAGE_A(PG8_SA(1, 0), cA + kstep, 0); PG8_STAGE_B(PG8_SB(1, 1), cB + HSTEP + kstep);
    PG8_WAIT_V(6); PG8_BAR;
    for (;;) {
        const bool has_next = S.next(ui + 1, nxt);
        const char* nA = has_next ? S.a_base(nxt) : cA; const char* nB = has_next ? S.b_base(nxt) : cB;
        for (int t = 0; t < NTK; t += 2) {
            const bool last = (t == NTK - 2);
            const char* a1 = cA + (size_t)(t + 1) * kstep;
            const char* a2 = last ? nA : cA + (size_t)(t + 2) * kstep; const char* b2 = last ? nB : cB + (size_t)(t + 2) * kstep;
            const char* a3 = a2 + kstep; const char* b3 = b2 + kstep;
            unsigned vn[4] = {va[0], va[1], va[2], va[3]};
            if (last && has_next) S.a_offs(nxt, natA, vn);
            PG8_LDB(B0, 0, 0); PG8_LDB(B1, 0, 1); PG8_SCHED; PG8_LDA(At, 0, 0); PG8_STAGE_A(PG8_SA(1, 1), a1, 1);
            PG8_WAIT_V(8); PG8_WAIT_L(0); PG8_BAR; PG8_MMA(0, 0, At, B0); PG8_MMA(0, 1, At, B1); PG8_BAR; PG8_SCHED;
            if (last) { va[0] = vn[0]; va[1] = vn[1]; va[2] = vn[2]; va[3] = vn[3]; }
            PG8_LDA(At, 0, 1); PG8_STAGE_B(PG8_SB(0, 0), b2); PG8_STAGE_B(PG8_SB(0, 1), b2 + HSTEP); PG8_STAGE_A(PG8_SA(0, 0), a2, 0);
            PG8_WAIT_V(8); PG8_WAIT_L(0); PG8_BAR; PG8_MMA(1, 0, At, B0); PG8_MMA(1, 1, At, B1); PG8_BAR; PG8_SCHED;
            PG8_LDB(B0, 1, 0); PG8_LDB(B1, 1, 1); PG8_SCHED; PG8_LDA(At, 1, 0); PG8_STAGE_A(PG8_SA(0, 1), a2, 1);
            PG8_WAIT_V(8); PG8_WAIT_L(0); PG8_BAR; PG8_MMA(0, 0, At, B0); PG8_MMA(0, 1, At, B1); PG8_BAR; PG8_SCHED;
            PG8_LDA(At, 1, 1); PG8_STAGE_B(PG8_SB(1, 0), b3); PG8_STAGE_B(PG8_SB(1, 1), b3 + HSTEP); PG8_STAGE_A(PG8_SA(1, 0), a3, 0);
            PG8_WAIT_V(8); PG8_WAIT_L(0); PG8_BAR; PG8_MMA(1, 0, At, B0); PG8_MMA(1, 1, At, B1); PG8_BAR; PG8_SCHED;
        }
        if (wr == 0) PG8_BAR;
        E(acc, cur, wr, wc, fr, fq);
        if (!has_next) break;
#pragma unroll
        for (int a = 0; a < 2; ++a)
#pragma unroll
            for (int b = 0; b < 2; ++b)
#pragma unroll
                for (int m = 0; m < 4; ++m)
#pragma unroll
                    for (int n = 0; n < 2; ++n) acc[a][b][m][n] = (f32x4){0.f, 0.f, 0.f, 0.f};
        cur = nxt; cA = nA; cB = nB; ++ui;
        if (wr == 1) PG8_BAR;
    }
    PG8_WAIT_V(0);
    PG8_BAR;
#undef PG8_SA
#undef PG8_SB
#undef PG8_STAGE_A
#undef PG8_STAGE_B
#undef PG8_LDA
#undef PG8_LDB
#undef PG8_MMA
#undef PG8_WAIT_V
#undef PG8_WAIT_L
#undef PG8_BAR
#undef PG8_SCHED
}
}

struct Args { const float* in[18]; float* out; unsigned char* ws; int ph_lo, ph_hi; };
struct Frame { LAS unsigned char* lds; int tid, lane, wave, vcu, G; };

__device__ __forceinline__ void transpose_item(const float* W, int ldw, int nvalid, bf16_t* WT, LAS float* scr, int kb, int nb, int lane) {
    const int k0 = 64 * kb, n0 = 32 * nb, nn = n0 + (lane & 31); const bool ok = nn < nvalid;
    const float* src = W + (size_t)(k0 + (lane >> 5)) * ldw + (ok ? nn : 0);
    float v[32];
#pragma unroll
    for (int i = 0; i < 32; ++i) v[i] = src[(size_t)(2 * i) * ldw];
#pragma unroll
    for (int i = 0; i < 32; ++i) scr[(2 * i + (lane >> 5)) * 33 + (lane & 31)] = ok ? v[i] : 0.f;
    LDS_WAIT(); asm volatile("" ::: "memory");
    const int c = lane & 7;
#pragma unroll
    for (int j = 0; j < 4; ++j) { const int n = (lane >> 3) + 8 * j; const LAS float* s = scr + (8 * c) * 33 + n;
        u32x4 o; o.x = cvt_pk_bf16(s[0 * 33], s[1 * 33]); o.y = cvt_pk_bf16(s[2 * 33], s[3 * 33]); o.z = cvt_pk_bf16(s[4 * 33], s[5 * 33]); o.w = cvt_pk_bf16(s[6 * 33], s[7 * 33]);
        *(u32x4*)(WT + (size_t)(n0 + n) * 2048 + k0 + 8 * c) = o; }
    LDS_WAIT(); asm volatile("" ::: "memory");
}
__device__ __forceinline__ float rms_load(const float* xrow, int lane, f32x4 (&v)[8]) {
    const f32x4* xr = (const f32x4*)xrow + lane; float s = 0.f;
#pragma unroll
    for (int j = 0; j < 8; ++j) { v[j] = xr[64 * j]; s += (v[j].x * v[j].x + v[j].y * v[j].y) + (v[j].z * v[j].z + v[j].w * v[j].w); }
    return rsqrtf(wave_sum(s) * (1.f / D) + EPS);
}

__device__ __forceinline__ void p0_prologue(const Frame& F, const Args& a) {
    LAS float* scr = (LAS float*)(F.lds + F.wave * 16384);
    const int gw = F.vcu * NWAVES + F.wave, NGW = F.G * NWAVES;
    const float* x = a.in[0]; const float* g_mix = a.in[1]; const float* w_in = a.in[2]; const float* w_out = a.in[9]; const float* w_gu = a.in[13]; const float* w_dn = a.in[15];
    bf16_t* WinT = (bf16_t*)(a.ws + WS_WIN); bf16_t* WoutT = (bf16_t*)(a.ws + WS_WOUT); bf16_t* WguT = (bf16_t*)(a.ws + WS_WGU); bf16_t* WdnT = (bf16_t*)(a.ws + WS_WDN); bf16_t* XN = (bf16_t*)(a.ws + WS_XN);
    for (int m = gw; m < S; m += NGW) { f32x4 v[8]; const float r = rms_load(x + (size_t)m * D, F.lane, v);
        const f32x4* gp = (const f32x4*)g_mix + F.lane; u32x2* o8 = (u32x2*)(XN + (size_t)m * D) + F.lane;
#pragma unroll
        for (int j = 0; j < 8; ++j) { const f32x4 g = gp[64 * j]; u32x2 w; w.x = cvt_pk_bf16(v[j].x * r * g.x, v[j].y * r * g.y); w.y = cvt_pk_bf16(v[j].z * r * g.z, v[j].w * r * g.w); o8[64 * j] = w; } }
    constexpr int I_IN = 32 * (NPAD / 32), I_OUT = 32 * (D / 32), I_GU = 32 * (2 * DFF / 32), I_DN = 32 * (D / 32);
    constexpr int NITEMS = I_IN + I_OUT + NE * I_GU + NE * I_DN;
    for (int it = gw; it < NITEMS; it += NGW) {
        int r = it;
        if (r < I_IN) { transpose_item(w_in, NPROJ, NPROJ, WinT, scr, r / (NPAD / 32), r % (NPAD / 32), F.lane); continue; } r -= I_IN;
        if (r < I_OUT) { transpose_item(w_out, D, D, WoutT, scr, r / (D / 32), r % (D / 32), F.lane); continue; } r -= I_OUT;
        if (r < NE * I_GU) { const int e = r / I_GU, q = r % I_GU; transpose_item(w_gu + (size_t)e * D * 2 * DFF, 2 * DFF, 2 * DFF, WguT + (size_t)e * 2 * DFF * D, scr, q / (2 * DFF / 32), q % (2 * DFF / 32), F.lane); continue; } r -= NE * I_GU;
        { const int e = r / I_DN, q = r % I_DN; transpose_item(w_dn + (size_t)e * DFF * D, D, D, WdnT + (size_t)e * D * DFF, scr, q / (D / 32), q % (D / 32), F.lane); }
    }
}

__device__ __forceinline__ void p2a_conv(const Frame& F, const Args& a) {
    const bf16_t* PROJ = (const bf16_t*)(a.ws + WS_PROJ); const float* DT = (const float*)(a.ws + WS_DT); float* DTS = (float*)(a.ws + WS_DTS); float* XB = (float*)(a.ws + WS_XBC);
    const float* cw = a.in[3]; const float* cb = a.in[4]; const float* dtb = a.in[5];
    const int gw = F.vcu * NWAVES + F.wave, NGW = F.G * NWAVES;
    for (int t = gw; t < S; t += NGW) {
#pragma unroll
        for (int j = 0; j < 3; ++j) { const int c = 8 * F.lane + 512 * j;
            float acc[8];
#pragma unroll
            for (int i = 0; i < 8; ++i) acc[i] = cb[c + i];
#pragma unroll
            for (int k = 0; k < 4; ++k) { const int tt = t - 3 + k; if (tt < 0) continue;
                const u32x4 xv = *(const u32x4*)(PROJ + (size_t)tt * NPJ + C_XBC + c); const float* w = cw + k * XBC + c;
                acc[0] = fmaf(w[0], bf_lo(xv.x), acc[0]); acc[1] = fmaf(w[1], bf_hi(xv.x), acc[1]); acc[2] = fmaf(w[2], bf_lo(xv.y), acc[2]); acc[3] = fmaf(w[3], bf_hi(xv.y), acc[3]);
                acc[4] = fmaf(w[4], bf_lo(xv.z), acc[4]); acc[5] = fmaf(w[5], bf_hi(xv.z), acc[5]); acc[6] = fmaf(w[6], bf_lo(xv.w), acc[6]); acc[7] = fmaf(w[7], bf_hi(xv.w), acc[7]); }
            f32x4 o0, o1; o0.x = silu_acc(acc[0]); o0.y = silu_acc(acc[1]); o0.z = silu_acc(acc[2]); o0.w = silu_acc(acc[3]); o1.x = silu_acc(acc[4]); o1.y = silu_acc(acc[5]); o1.z = silu_acc(acc[6]); o1.w = silu_acc(acc[7]);
            *(f32x4*)(XB + (size_t)t * XBC + c) = o0; *(f32x4*)(XB + (size_t)t * XBC + c + 4) = o1; }
        if (F.lane < H) DTS[t * H + F.lane] = softplus_acc(DT[t * H + F.lane] + dtb[F.lane]);
    }
}

__device__ __forceinline__ void ssm_seq(const Args& a, int h, int pq, int tid) {
    const float* xbc = (const float*)(a.ws + WS_XBC); const float* dts = (const float*)(a.ws + WS_DTS); float* Y = (float*)(a.ws + WS_YRAW);
    const int pl = tid >> 4, ng = tid & 15, p = pq * 16 + pl, g = h >> 3;
    const float av = -expf(a.in[6][h]), dsk = a.in[7][h];
    float st[8];
#pragma unroll
    for (int i = 0; i < 8; ++i) st[i] = 0.f;
#pragma unroll 4
    for (int t = 0; t < S; ++t) {
        const float dt = dts[t * H + h]; const float x = xbc[(size_t)t * XBC + h * HD + p];
        const float dec = expf(dt * av), xd = x * dt;
        const f32x4* Bp = (const f32x4*)(xbc + (size_t)t * XBC + 1024 + g * NST + ng * 8); const f32x4* Cp = (const f32x4*)(xbc + (size_t)t * XBC + 1280 + g * NST + ng * 8);
        const f32x4 b0 = Bp[0], b1 = Bp[1], c0 = Cp[0], c1 = Cp[1];
        const float bb[8] = {b0.x, b0.y, b0.z, b0.w, b1.x, b1.y, b1.z, b1.w}, cc[8] = {c0.x, c0.y, c0.z, c0.w, c1.x, c1.y, c1.z, c1.w};
        float y = 0.f;
#pragma unroll
        for (int i = 0; i < 8; ++i) { st[i] = fmaf(st[i], dec, bb[i] * xd); y = fmaf(cc[i], st[i], y); }
        y += __shfl_xor(y, 1); y += __shfl_xor(y, 2); y += __shfl_xor(y, 4); y += __shfl_xor(y, 8);
        if (ng == 0) Y[(size_t)t * 1024 + h * HD + p] = y + dsk * x;
    }
}

__device__ __forceinline__ void attn_unit(const Args& a, int h, int t0, int lane) {
    const bf16_t* PROJ = (const bf16_t*)(a.ws + WS_PROJ); bf16_t* MIX = (bf16_t*)(a.ws + WS_MIX);
    const int t = t0 + lane;
    float q[64], o[64];
    { const u32x4* qp = (const u32x4*)(PROJ + (size_t)t * NPJ + h * HD);
#pragma unroll
        for (int i = 0; i < 8; ++i) { const u32x4 u = qp[i]; q[8 * i + 0] = bf_lo(u.x) * 0.125f; q[8 * i + 1] = bf_hi(u.x) * 0.125f; q[8 * i + 2] = bf_lo(u.y) * 0.125f; q[8 * i + 3] = bf_hi(u.y) * 0.125f;
            q[8 * i + 4] = bf_lo(u.z) * 0.125f; q[8 * i + 5] = bf_hi(u.z) * 0.125f; q[8 * i + 6] = bf_lo(u.w) * 0.125f; q[8 * i + 7] = bf_hi(u.w) * 0.125f; } }
#pragma unroll
    for (int d = 0; d < 64; ++d) o[d] = 0.f;
    float carry = 0.f;
    for (int s = t0 + 62; s >= 0; --s) {
        const u32x4* kp = (const u32x4*)(PROJ + (size_t)s * NPJ + C_K + h * HD); const u32x4* vp = (const u32x4*)(PROJ + (size_t)s * NPJ + C_V + h * HD);
        float l = 0.f;
#pragma unroll
        for (int i = 0; i < 8; ++i) { const u32x4 u = kp[i]; l = fmaf(q[8 * i + 0], bf_lo(u.x), l); l = fmaf(q[8 * i + 1], bf_hi(u.x), l); l = fmaf(q[8 * i + 2], bf_lo(u.y), l); l = fmaf(q[8 * i + 3], bf_hi(u.y), l);
            l = fmaf(q[8 * i + 4], bf_lo(u.z), l); l = fmaf(q[8 * i + 5], bf_hi(u.z), l); l = fmaf(q[8 * i + 6], bf_lo(u.w), l); l = fmaf(q[8 * i + 7], bf_hi(u.w), l); }
        const bool act = s < t;
        const float lk = -(fmaxf(l, 0.f) + __logf(1.f + __expf(-fabsf(l))));
        const float w = act ? __expf(l + lk + carry) : 0.f;
        carry += act ? lk : 0.f;
#pragma unroll
        for (int i = 0; i < 8; ++i) { const u32x4 u = vp[i]; o[8 * i + 0] = fmaf(w, bf_lo(u.x), o[8 * i + 0]); o[8 * i + 1] = fmaf(w, bf_hi(u.x), o[8 * i + 1]); o[8 * i + 2] = fmaf(w, bf_lo(u.y), o[8 * i + 2]); o[8 * i + 3] = fmaf(w, bf_hi(u.y), o[8 * i + 3]);
            o[8 * i + 4] = fmaf(w, bf_lo(u.z), o[8 * i + 4]); o[8 * i + 5] = fmaf(w, bf_hi(u.z), o[8 * i + 5]); o[8 * i + 6] = fmaf(w, bf_lo(u.w), o[8 * i + 6]); o[8 * i + 7] = fmaf(w, bf_hi(u.w), o[8 * i + 7]); }
        if (__all(carry < -104.f)) break;
    }
    u32x4* op = (u32x4*)(MIX + (size_t)t * D + h * HD);
#pragma unroll
    for (int i = 0; i < 8; ++i) { u32x4 w; w.x = cvt_pk_bf16(o[8 * i + 0], o[8 * i + 1]); w.y = cvt_pk_bf16(o[8 * i + 2], o[8 * i + 3]); w.z = cvt_pk_bf16(o[8 * i + 4], o[8 * i + 5]); w.w = cvt_pk_bf16(o[8 * i + 6], o[8 * i + 7]); op[i] = w; }
}

__device__ __forceinline__ void p2b_mix(const Frame& F, const Args& a) {
    unsigned* ctl = (unsigned*)(a.ws + WS_CTL);
    if (blockIdx.x < 64 && F.wave < 4) { ssm_seq(a, blockIdx.x >> 2, blockIdx.x & 3, F.tid); return; }
    for (;;) {
        int u = 0; if (F.lane == 0) u = (int)__hip_atomic_fetch_add(ctl + CW_ATTQ, 1u, RLX_AGENT);
        u = __builtin_amdgcn_readfirstlane(u);
        if (u >= H * (S / 64)) break;
        const int blk = (S / 64 - 1) - (u / H), h = u % H;
        attn_unit(a, h, blk * 64, F.lane);
    }
}

__device__ __forceinline__ void p4_gate(const Frame& F, const Args& a) {
    const bf16_t* PROJ = (const bf16_t*)(a.ws + WS_PROJ); const float* Y = (const float*)(a.ws + WS_YRAW); bf16_t* MIX = (bf16_t*)(a.ws + WS_MIX); const float* g_ssm = a.in[8];
    const int gw = F.vcu * NWAVES + F.wave, NGW = F.G * NWAVES;
    for (int t = gw; t < S; t += NGW) {
        const int c = 16 * F.lane;
        const f32x4* yp = (const f32x4*)(Y + (size_t)t * 1024 + c); const u32x4* zp = (const u32x4*)(PROJ + (size_t)t * NPJ + C_Z + c);
        float v[16];
        { const f32x4 y0 = yp[0], y1 = yp[1], y2 = yp[2], y3 = yp[3]; const u32x4 z0 = zp[0], z1 = zp[1];
          const float yy[16] = {y0.x, y0.y, y0.z, y0.w, y1.x, y1.y, y1.z, y1.w, y2.x, y2.y, y2.z, y2.w, y3.x, y3.y, y3.z, y3.w};
          const float zz[16] = {bf_lo(z0.x), bf_hi(z0.x), bf_lo(z0.y), bf_hi(z0.y), bf_lo(z0.z), bf_hi(z0.z), bf_lo(z0.w), bf_hi(z0.w), bf_lo(z1.x), bf_hi(z1.x), bf_lo(z1.y), bf_hi(z1.y), bf_lo(z1.z), bf_hi(z1.z), bf_lo(z1.w), bf_hi(z1.w)};
#pragma unroll
          for (int i = 0; i < 16; ++i) v[i] = yy[i] * silu_acc(zz[i]); }
        float s = 0.f;
#pragma unroll
        for (int i = 0; i < 16; ++i) s += v[i] * v[i];
#pragma unroll
        for (int o = 1; o < 32; o <<= 1) s += __shfl_xor(s, o);
        const float r = rsqrtf(s * (1.f / 512.f) + EPS);
        const f32x4* gp = (const f32x4*)(g_ssm + c);
        u32x4 w0, w1; { const f32x4 g0 = gp[0], g1 = gp[1], g2 = gp[2], g3 = gp[3];
          w0.x = cvt_pk_bf16(v[0] * r * g0.x, v[1] * r * g0.y); w0.y = cvt_pk_bf16(v[2] * r * g0.z, v[3] * r * g0.w); w0.z = cvt_pk_bf16(v[4] * r * g1.x, v[5] * r * g1.y); w0.w = cvt_pk_bf16(v[6] * r * g1.z, v[7] * r * g1.w);
          w1.x = cvt_pk_bf16(v[8] * r * g2.x, v[9] * r * g2.y); w1.y = cvt_pk_bf16(v[10] * r * g2.z, v[11] * r * g2.w); w1.z = cvt_pk_bf16(v[12] * r * g3.x, v[13] * r * g3.y); w1.w = cvt_pk_bf16(v[14] * r * g3.z, v[15] * r * g3.w); }
        u32x4* op = (u32x4*)(MIX + (size_t)t * D + 1024 + c); op[0] = w0; op[1] = w1;
    }
}

__device__ __forceinline__ void p6_router(const Frame& F, const Args& a) {
    const float* X2 = (const float*)(a.ws + WS_X2); bf16_t* H2 = (bf16_t*)(a.ws + WS_H2); const float* g_ffn = a.in[10]; const float* wr = a.in[11]; const float* br = a.in[12];
    unsigned* cnt = (unsigned*)(a.ws + WS_CTL) + CW_CNT; int* tokof = (int*)(a.ws + WS_TOKOF); int* TE = (int*)(a.ws + WS_TE); int* TP = (int*)(a.ws + WS_TP); float* TG = (float*)(a.ws + WS_TG);
    const int gw = F.vcu * NWAVES + F.wave, NGW = F.G * NWAVES;
    for (int t = gw; t < S; t += NGW) {
        f32x4 v[8]; const float r = rms_load(X2 + (size_t)t * D, F.lane, v);
        const f32x4* gp = (const f32x4*)g_ffn + F.lane; u32x2* o8 = (u32x2*)(H2 + (size_t)t * D) + F.lane;
        float lg[32];
#pragma unroll
        for (int e = 0; e < 32; ++e) lg[e] = 0.f;
#pragma unroll
        for (int j = 0; j < 8; ++j) { const f32x4 g = gp[64 * j]; v[j].x *= r * g.x; v[j].y *= r * g.y; v[j].z *= r * g.z; v[j].w *= r * g.w;
            u32x2 w; w.x = cvt_pk_bf16(v[j].x, v[j].y); w.y = cvt_pk_bf16(v[j].z, v[j].w); o8[64 * j] = w;
            const float hv[4] = {v[j].x, v[j].y, v[j].z, v[j].w};
#pragma unroll
            for (int i = 0; i < 4; ++i) { const f32x4* wp = (const f32x4*)(wr + (size_t)(4 * F.lane + 256 * j + i) * NE);
#pragma unroll
                for (int e4 = 0; e4 < 8; ++e4) { const f32x4 w4 = wp[e4]; lg[4 * e4 + 0] = fmaf(hv[i], w4.x, lg[4 * e4 + 0]); lg[4 * e4 + 1] = fmaf(hv[i], w4.y, lg[4 * e4 + 1]); lg[4 * e4 + 2] = fmaf(hv[i], w4.z, lg[4 * e4 + 2]); lg[4 * e4 + 3] = fmaf(hv[i], w4.w, lg[4 * e4 + 3]); } } }
#pragma unroll
        for (int e = 0; e < 32; ++e) lg[e] = wave_sum(lg[e]) + br[e];
        int sel[4]; float sv[4];
#pragma unroll
        for (int k = 0; k < 4; ++k) { float bv = -3.4e38f; int bi = 0;
#pragma unroll
            for (int e = 0; e < 32; ++e) { const bool gt = lg[e] > bv; bv = gt ? lg[e] : bv; bi = gt ? e : bi; }
#pragma unroll
            for (int e = 0; e < 32; ++e) lg[e] = (e == bi) ? -3.4e38f : lg[e];
            sel[k] = bi; sv[k] = bv; }
        const float e1 = expf(sv[1] - sv[0]), e2 = expf(sv[2] - sv[0]), e3 = expf(sv[3] - sv[0]); const float inv = 1.f / (1.f + e1 + e2 + e3);
        if (F.lane < 4) { const int me = F.lane == 0 ? sel[0] : F.lane == 1 ? sel[1] : F.lane == 2 ? sel[2] : sel[3]; const float mg = (F.lane == 0 ? 1.f : F.lane == 1 ? e1 : F.lane == 2 ? e2 : e3) * inv;
            const int pos = (int)__hip_atomic_fetch_add(cnt + me, 1u, RLX_AGENT);
            tokof[me * ECAP + pos] = t; TE[t * 4 + F.lane] = me; TP[t * 4 + F.lane] = pos; TG[t * 4 + F.lane] = mg; }
    }
}

__device__ __forceinline__ void moe_tables(const Frame& F, const Args& a, int ntn) {
    LAS int* T = (LAS int*)(F.lds + LDSCTL_OFF);
    unsigned* cnt = (unsigned*)(a.ws + WS_CTL) + CW_CNT;
    __syncthreads();
    if (F.tid == 0) { int pu = 0, po = 0;
        for (int e = 0; e < NE; ++e) { const int c = (int)__hip_atomic_load(cnt + e, RLX_AGENT); const int mt = (c + 255) >> 8; T[L_CNT + e] = c; T[L_PFXU + e] = pu; T[L_POFF + e] = po; pu += mt * ntn; po += mt * 256; }
        T[L_PFXU + NE] = pu; T[L_POFF + NE] = po; }
    __syncthreads();
}

__device__ __forceinline__ void p9_final(const Frame& F, const Args& a) {
    const float* X2 = (const float*)(a.ws + WS_X2); const bf16_t* YS = (const bf16_t*)(a.ws + WS_YS); const int* TE = (const int*)(a.ws + WS_TE); const int* TP = (const int*)(a.ws + WS_TP); const float* TG = (const float*)(a.ws + WS_TG);
    const float* g_final = a.in[17]; const LAS int* T = (const LAS int*)(F.lds + LDSCTL_OFF);
    const int gw = F.vcu * NWAVES + F.wave, NGW = F.G * NWAVES;
    for (int t = gw; t < S; t += NGW) {
        f32x4 v[8]; const f32x4* xr = (const f32x4*)(X2 + (size_t)t * D) + F.lane;
#pragma unroll
        for (int j = 0; j < 8; ++j) v[j] = xr[64 * j];
#pragma unroll
        for (int k = 0; k < 4; ++k) { const int e = TE[t * 4 + k], pos = TP[t * 4 + k]; const float g = TG[t * 4 + k];
            const u32x2* yp = (const u32x2*)(YS + (size_t)(T[L_POFF + e] + pos) * D) + F.lane;
#pragma unroll
            for (int j = 0; j < 8; ++j) { const u32x2 y = yp[64 * j]; v[j].x = fmaf(g, bf_lo(y.x), v[j].x); v[j].y = fmaf(g, bf_hi(y.x), v[j].y); v[j].z = fmaf(g, bf_lo(y.y), v[j].z); v[j].w = fmaf(g, bf_hi(y.y), v[j].w); } }
        float s = 0.f;
#pragma unroll
        for (int j = 0; j < 8; ++j) s += (v[j].x * v[j].x + v[j].y * v[j].y) + (v[j].z * v[j].z + v[j].w * v[j].w);
        const float r = rsqrtf(wave_sum(s) * (1.f / D) + EPS);
        const f32x4* gp = (const f32x4*)g_final + F.lane; f32x4* op = (f32x4*)(a.out + (size_t)t * D) + F.lane;
#pragma unroll
        for (int j = 0; j < 8; ++j) { const f32x4 g = gp[64 * j]; f32x4 o; o.x = v[j].x * r * g.x; o.y = v[j].y * r * g.y; o.z = v[j].z * r * g.z; o.w = v[j].w * r * g.w; op[64 * j] = o; }
    }
}

constexpr int NPHASE = 10;
__global__ void __launch_bounds__(NT, 2) mk_fwd(Args args) {
    extern __shared__ __attribute__((aligned(16))) unsigned char lds_raw[];
    Frame F; F.lds = (LAS unsigned char*)lds_raw; F.tid = threadIdx.x; F.lane = F.tid & 63; F.wave = __builtin_amdgcn_readfirstlane(F.tid >> 6);
    F.G = gridDim.x; { const int bx = blockIdx.x; F.vcu = (F.G % 8 == 0) ? (bx % 8) * (F.G / 8) + bx / 8 : bx; }
    unsigned char* ws = args.ws;
    for (int u = F.tid; u < (LDS_BYTES - LDSCTL_OFF) / 4; u += NT) ((LAS unsigned*)(F.lds + LDSCTL_OFF))[u] = 0u;
    __syncthreads();
    XcdBarrier bar; bar.bar = (unsigned*)(ws + WS_CTL) + CW_BAR; bar.x = 0; bar.st = nullptr;
    if (!MK_SPLIT) bar = xcd_barrier_post((unsigned*)(ws + WS_CTL) + CW_BAR, (volatile LAS unsigned*)(F.lds + LDSCTL_OFF) + L_MISC + 8);
    const int lo = args.ph_lo, hi = args.ph_hi;
#define IN(k) (lo <= (k) && (k) < hi)
#define SEAM(k) do { if (IN(k) && IN((k) + 1)) xcd_barrier(bar); } while (0)
    const LAS int* T = (const LAS int*)(F.lds + LDSCTL_OFF);
    if (IN(0)) { p0_prologue(F, args); } SEAM(0);
    if (IN(1)) { pg8::NatOrder So; So.init(ws + WS_XN, ws + WS_WIN, S, NPAD, F.G, (int)blockIdx.x); pg8::EpiProj E{(bf16_t*)(ws + WS_PROJ), (float*)(ws + WS_DT)};
        pg8::gemm_phase<pg8::EpiProj, pg8::NatOrder>(F.lds, So, E); } SEAM(1);
    if (IN(2)) { p2a_conv(F, args); } SEAM(2);
    if (IN(3)) { p2b_mix(F, args); } SEAM(3);
    if (IN(4)) { p4_gate(F, args); } SEAM(4);
    if (IN(5)) { pg8::NatOrder So; So.init(ws + WS_MIX, ws + WS_WOUT, S, D, F.G, (int)blockIdx.x); pg8::EpiRes E{args.in[0], (float*)(ws + WS_X2)};
        pg8::gemm_phase<pg8::EpiRes, pg8::NatOrder>(F.lds, So, E); } SEAM(5);
    if (IN(6)) { p6_router(F, args); } SEAM(6);
    if (IN(7)) { moe_tables(F, args, 16);
        pg8::MoeOrder<true> So{(const char*)(ws + WS_H2), (const char*)(ws + WS_WGU), (const int*)(ws + WS_TOKOF), T + L_CNT, T + L_PFXU, T + L_POFF, 16, F.G, F.vcu};
        pg8::EpiGU E{(bf16_t*)(ws + WS_ACT), args.in[14], T + L_POFF};
        pg8::gemm_phase<pg8::EpiGU, pg8::MoeOrder<true>>(F.lds, So, E); } SEAM(7);
    if (IN(8)) { moe_tables(F, args, 8);
        pg8::MoeOrder<false> So{(const char*)(ws + WS_ACT), (const char*)(ws + WS_WDN), nullptr, T + L_CNT, T + L_PFXU, T + L_POFF, 8, F.G, F.vcu};
        pg8::EpiDown E{(bf16_t*)(ws + WS_YS), args.in[16], T + L_POFF};
        pg8::gemm_phase<pg8::EpiDown, pg8::MoeOrder<false>>(F.lds, So, E); } SEAM(8);
    if (IN(9)) { moe_tables(F, args, 8); p9_final(F, args); }
#undef IN
#undef SEAM
}

extern "C" void kernel_launch(void* const* d_in, const int* in_sizes, int n_in, void* d_out, int out_size, void* d_ws, size_t ws_size, hipStream_t stream) {
    static int grid = 0;
    if (grid == 0) {
        if (n_in != 18 || out_size != S * D || ws_size < WS_END) { fprintf(stderr, "kernel_launch: unexpected problem (n_in %d out %d ws %zu need %zu)\n", n_in, out_size, ws_size, (size_t)WS_END); grid = -1; return; }
        int dev = 0, cus = 0, per_cu = 0;
        if (hipGetDevice(&dev) != hipSuccess || hipDeviceGetAttribute(&cus, hipDeviceAttributeMultiprocessorCount, dev) != hipSuccess) { grid = -1; return; }
        if (hipFuncSetAttribute((const void*)mk_fwd, hipFuncAttributeMaxDynamicSharedMemorySize, LDS_BYTES) != hipSuccess) { fprintf(stderr, "kernel_launch: hipFuncSetAttribute failed\n"); grid = -1; return; }
        if (hipOccupancyMaxActiveBlocksPerMultiprocessor(&per_cu, (const void*)mk_fwd, NT, LDS_BYTES) != hipSuccess || per_cu < 1) { fprintf(stderr, "kernel_launch: occupancy query says %d\n", per_cu); }
        (void)hipGetLastError();
        grid = cus;
    }
    if (grid < 0) return;
    if (hipMemsetAsync((char*)d_ws + WS_CTL, 0, CTL_ZERO_BYTES, stream) != hipSuccess) return;
    Args a; memset(&a, 0, sizeof a);
    for (int i = 0; i < 18; ++i) a.in[i] = (const float*)d_in[i];
    a.out = (float*)d_out; a.ws = (unsigned char*)d_ws;
#if MK_SPLIT
    for (int p = 0; p < NPHASE; ++p) { a.ph_lo = p; a.ph_hi = p + 1; hipLaunchKernelGGL(mk_fwd, dim3(grid), dim3(NT), LDS_BYTES, stream, a); }
#else
    a.ph_lo = 0; a.ph_hi = NPHASE; hipLaunchKernelGGL(mk_fwd, dim3(grid), dim3(NT), LDS_BYTES, stream, a);
#endif
}
```

```cpp
#include <hip/hip_runtime.h>
#include <cstdio>
#include <cstdint>
#include <cstring>

#ifndef MK_SPLIT
#define MK_SPLIT 0
#endif

#define LAS __attribute__((address_space(3)))
#define GAS __attribute__((address_space(1)))
typedef unsigned short bf16_t;
typedef short bf16x8 __attribute__((ext_vector_type(8)));
typedef float f32x4 __attribute__((ext_vector_type(4)));
typedef float f32x2 __attribute__((ext_vector_type(2)));
typedef unsigned u32x4 __attribute__((ext_vector_type(4)));
typedef unsigned u32x2 __attribute__((ext_vector_type(2)));

constexpr int S = 8192, D = 2048, H = 16, HD = 64, NE = 32, DFF = 2048;
constexpr int NPJ = 5632;
constexpr int NPAD = 5888;
constexpr int NPROJ = 5648;
constexpr int C_K = 1024, C_V = 2048, C_Z = 3072, C_XBC = 4096;
constexpr int XBC = 1536, NST = 128, NCH = 128, CL = 64;
constexpr float EPS = 1e-5f;
constexpr int ECAP = 8192;
constexpr int MAXROWS = S * 4 + NE * 256;

constexpr size_t MiB = 1u << 20;
constexpr size_t WS_CTL = 0, CTL_ZERO_BYTES = 1 * MiB;
constexpr size_t WS_WIN = 2 * MiB;
constexpr size_t WS_WOUT = WS_WIN + (size_t)NPAD * D * 2;
constexpr size_t WS_WGU = WS_WOUT + (size_t)D * D * 2;
constexpr size_t WS_WDN = WS_WGU + (size_t)NE * 2 * DFF * D * 2;
constexpr size_t WS_XN = WS_WDN + (size_t)NE * D * DFF * 2;
constexpr size_t WS_PROJ = WS_XN + (size_t)S * D * 2;
constexpr size_t WS_DT = WS_PROJ + (size_t)S * NPJ * 2;
constexpr size_t WS_ACUM = WS_DT + (size_t)S * H * 4;
constexpr size_t WS_DEC = WS_ACUM + (size_t)S * H * 4;
constexpr size_t WS_CC = WS_DEC + (size_t)NCH * H * 4;
constexpr size_t WS_Y0 = WS_CC + (size_t)S * 256 * 2;
constexpr size_t WS_SC = WS_Y0 + (size_t)S * 1024 * 4;
constexpr size_t WS_PREV = WS_SC + (size_t)NCH * H * 8192 * 2;
constexpr size_t WS_MIX = WS_PREV + (size_t)NCH * H * 8192 * 2;
constexpr size_t WS_X2 = WS_MIX + (size_t)S * D * 2;
constexpr size_t WS_H2 = WS_X2 + (size_t)S * D * 4;
constexpr size_t WS_TOKOF = WS_H2 + (size_t)S * D * 2;
constexpr size_t WS_TE = WS_TOKOF + (size_t)NE * ECAP * 4;
constexpr size_t WS_TP = WS_TE + (size_t)S * 4 * 4;
constexpr size_t WS_TG = WS_TP + (size_t)S * 4 * 4;
constexpr size_t WS_ACT = WS_TG + (size_t)S * 4 * 4;
constexpr size_t WS_YS = WS_ACT + (size_t)MAXROWS * DFF * 2;
constexpr size_t WS_END = WS_YS + (size_t)MAXROWS * D * 2;
constexpr int CW_BAR = 4096;
constexpr int CW_CNT = 8192;
constexpr int CW_ATTQ = 8448;

constexpr int RING_BYTES = 131072;
constexpr int LDSCTL_OFF = RING_BYTES;
constexpr int L_MISC = 0;
constexpr int L_CNT = 64, L_PFXU = 128, L_POFF = 192;
constexpr int LDS_BYTES = 147456;
constexpr int NWAVES = 8, NT = 512;

#define LDS_WAIT() asm volatile("s_waitcnt lgkmcnt(0)" ::: "memory")
#define VM_WAIT() asm volatile("s_waitcnt vmcnt(0)" ::: "memory")
#define RLX_AGENT __ATOMIC_RELAXED, __HIP_MEMORY_SCOPE_AGENT
typedef __bf16 bf16v2 __attribute__((ext_vector_type(2)));
__device__ __forceinline__ unsigned cvt_pk_bf16(float lo, float hi) { f32x2 v = {lo, hi}; bf16v2 r = __builtin_convertvector(v, bf16v2); return __builtin_bit_cast(unsigned, r); }
__device__ __forceinline__ float bf_lo(unsigned u) { return __builtin_bit_cast(float, u << 16); }
__device__ __forceinline__ float bf_hi(unsigned u) { return __builtin_bit_cast(float, u & 0xffff0000u); }
__device__ __forceinline__ float wave_sum(float v) {
#pragma unroll
    for (int o = 1; o < 64; o <<= 1) v += __shfl_xor(v, o);
    return v;
}
__device__ __forceinline__ float softplus_acc(float x) { return fmaxf(x, 0.f) + log1pf(expf(-fabsf(x))); }
__device__ __forceinline__ float silu_acc(float x) { return x / (1.f + expf(-x)); }

#define XB_TMO      128
#define XB_XCNT(j)  (256  + 64 * (j))
#define XB_XSUB(j)  (1280 + 64 * (j))
#define XB_XGEN(j)  (2304 + 64 * (j))
#define XB_TOP      3328
#define XB_TOPGEN   3392
#define XCD_BAR_WORDS 3456
#define XB_SPIN_CAP (1u << 18)
__device__ __forceinline__ unsigned xb_ld(unsigned* p)              { return __hip_atomic_load(p, __ATOMIC_RELAXED, __HIP_MEMORY_SCOPE_AGENT); }
__device__ __forceinline__ unsigned xb_add(unsigned* p, unsigned v) { return __hip_atomic_fetch_add(p, v, __ATOMIC_RELAXED, __HIP_MEMORY_SCOPE_AGENT); }
__device__ __forceinline__ unsigned xb_xcc_id() { return (unsigned)__builtin_amdgcn_s_getreg((3 << 11) | 20) & 0xFu; }
#define XB_SPIN(cond, bar) do { unsigned _sp = 0; while (cond) { __builtin_amdgcn_s_sleep(1); \
    if ((++_sp & 255u) == 0u) { if (xb_ld(&(bar)[XB_TMO])) break; if (_sp > XB_SPIN_CAP) { atomicAdd(&(bar)[XB_TMO], 1u); break; } } } } while (0)
struct XcdBarrier { unsigned* bar; unsigned x; volatile LAS unsigned* st; };
__device__ __forceinline__ XcdBarrier xcd_barrier_post(unsigned* bar, volatile LAS unsigned* st) {
    XcdBarrier b; b.bar = bar; b.x = xb_xcc_id(); b.st = st;
    if (threadIdx.x == 0) (void)xb_add(&bar[XB_XCNT(b.x)], 1u);
    return b;
}
__device__ __forceinline__ void xcd_barrier_complete(unsigned* bar, unsigned x, unsigned& nloc, unsigned& nx) {
    const unsigned G = gridDim.x * gridDim.y * gridDim.z;
    unsigned sum, cnt, mine, sp = 0u;
    for (;;) {
        sum = 0u; cnt = 0u; mine = 0u;
#pragma unroll
        for (unsigned j = 0; j < 16; ++j) { const unsigned c = xb_ld(&bar[XB_XCNT(j)]); sum += c; cnt += (c > 0u) ? 1u : 0u; mine = (j == x) ? c : mine; }
        if (sum == G) break;
        __builtin_amdgcn_s_sleep(1);
        if ((++sp & 255u) == 0u) { if (xb_ld(&bar[XB_TMO])) break; if (sp > XB_SPIN_CAP) { atomicAdd(&bar[XB_TMO], 1u); break; } }
    }
    nloc = mine > 0u ? mine : 1u; nx = cnt > 0u ? cnt : 1u;
}
__device__ __forceinline__ void xcd_barrier(const XcdBarrier& b) {
    asm volatile("s_waitcnt vmcnt(0)" ::: "memory");
    __syncthreads();
    if (threadIdx.x == 0) {
        unsigned* bar = b.bar;
        __builtin_amdgcn_s_waitcnt(0);
        unsigned nloc = b.st[0], nx = b.st[1];
        if (nloc == 0u) { xcd_barrier_complete(bar, b.x, nloc, nx); b.st[0] = nloc; b.st[1] = nx; }
        const unsigned old = xb_add(&bar[XB_XSUB(b.x)], 1u);
        const unsigned gen = old / nloc;
        if (old + 1u == (gen + 1u) * nloc) {
            __builtin_amdgcn_fence(__ATOMIC_RELEASE, "agent");
            asm volatile("s_waitcnt vmcnt(0)" ::: "memory");
            const unsigned og = xb_add(&bar[XB_TOP], 1u);
            const unsigned tg = og / nx;
            if (og + 1u == (tg + 1u) * nx) xb_add(&bar[XB_TOPGEN], 1u);
            else XB_SPIN(xb_ld(&bar[XB_TOPGEN]) == tg, bar);
            __builtin_amdgcn_fence(__ATOMIC_ACQUIRE, "agent");
            xb_add(&bar[XB_XGEN(b.x)], 1u);
            asm volatile("s_waitcnt vmcnt(0)" ::: "memory");
        } else {
            XB_SPIN(xb_ld(&bar[XB_XGEN(b.x)]) == gen, bar);
            __builtin_amdgcn_fence(__ATOMIC_ACQUIRE, "agent");
            asm volatile("s_waitcnt vmcnt(0)" ::: "memory");
        }
    }
    __syncthreads();
}

namespace pg8 {
constexpr int BM = 256, BK = 64, HALF = 128, HTB = HALF * BK * 2, NXCD = 8, WGM = 8, K = 2048, NTK = K / BK;
constexpr unsigned HSTEP = (unsigned)HALF * K * 2;
constexpr size_t TSTEP = 2 * (size_t)HSTEP;
__host__ __device__ __forceinline__ int lds_byte(int r, int c) { const int st = (r >> 4) * 2 + (c >> 5), rr = r & 15, cc = c & 31, ob = rr * 64 + cc * 2; return st * 1024 + (ob ^ (((ob >> 9) & 1) << 5)); }
__host__ __device__ __forceinline__ void stage_rc(int b, int& R, int& C) { const int st = b / 1024, sb = b % 1024, swz = sb ^ (((sb >> 9) & 1) << 5); R = (st >> 1) * 16 + swz / 64; C = (st & 1) * 32 + (swz % 64) / 2; }
__host__ __device__ __forceinline__ int perm32(int rho) { const int n = rho >> 4, i = rho & 15; return 8 * (i >> 2) + 4 * n + (i & 3); }
struct Unit { int pm, pn, e; };

struct NatOrder {
    const char* A; const char* Bt; int nM, nN, nwg, G, c;
    __device__ void init(const void* A_, const void* Bt_, int M, int N, int G_, int c_) { A = (const char*)A_; Bt = (const char*)Bt_; nM = M / BM; nN = N / BM; nwg = nM * nN; G = G_; c = c_; }
    __device__ __forceinline__ bool next(int i, Unit& u) const {
        const long L = (long)i * G + c; if (L >= nwg) return false;
        int wgid = (int)L; { const int q = nwg / NXCD, r = nwg % NXCD, xcd = wgid % NXCD, off = wgid / NXCD; wgid = (xcd < r ? xcd * (q + 1) : r * (q + 1) + (xcd - r) * q) + off; }
        const int nig = WGM * nN, gid = wgid / nig, fm = gid * WGM, gsz = (nM - fm) < WGM ? (nM - fm) : WGM;
        u.pm = fm + ((wgid % nig) % gsz); u.pn = (wgid % nig) / gsz; u.e = 0; return true;
    }
    __device__ __forceinline__ const char* a_base(const Unit& u) const { return A + (size_t)u.pm * TSTEP; }
    __device__ __forceinline__ const char* b_base(const Unit& u) const { return Bt + (size_t)u.pn * TSTEP; }
    __device__ __forceinline__ void a_offs(const Unit&, const unsigned (&nat)[2], unsigned (&v)[4]) const { v[0] = nat[0]; v[1] = nat[1]; v[2] = nat[0] + HSTEP; v[3] = nat[1] + HSTEP; }
};
template <bool GATHER> struct MoeOrder {
    const char* A; const char* Bt; const int* tokof; const LAS int* cnt; const LAS int* pfxU; const LAS int* poff; int ntn, G, c;
    __device__ __forceinline__ bool next(int i, Unit& u) const {
        const int L = i * G + c; if (L >= pfxU[NE]) return false;
        int e = 0;
#pragma unroll 1
        for (; e < NE - 1; ++e) if (L < pfxU[e + 1]) break;
        const int r = L - pfxU[e], mt = (cnt[e] + 255) >> 8;
        u.e = e; u.pn = r / mt; u.pm = r - u.pn * mt; return true;
    }
    __device__ __forceinline__ const char* a_base(const Unit& u) const { return GATHER ? A : A + ((size_t)poff[u.e] + (size_t)u.pm * BM) * (K * 2); }
    __device__ __forceinline__ const char* b_base(const Unit& u) const { return Bt + ((size_t)u.e * ntn + u.pn) * TSTEP; }
    __device__ __forceinline__ void a_offs(const Unit& u, const unsigned (&nat)[2], unsigned (&v)[4]) const {
        if (!GATHER) { v[0] = nat[0]; v[1] = nat[1]; v[2] = nat[0] + HSTEP; v[3] = nat[1] + HSTEP; return; }
        const int n = cnt[u.e];
#pragma unroll
        for (int h = 0; h < 2; ++h)
#pragma unroll
            for (int i = 0; i < 2; ++i) { const unsigned R = nat[i] / (K * 2), Cb = nat[i] % (K * 2); int pos = u.pm * BM + h * HALF + (int)R; pos = pos < n ? pos : n - 1;
                const int tok = tokof[u.e * ECAP + pos]; v[h * 2 + i] = (unsigned)tok * (K * 2) + Cb; }
    }
};

struct EpiProj {
    static constexpr bool PERM = true;
    bf16_t* P; float* DT;
    __device__ __forceinline__ void operator()(const f32x4 (&acc)[2][2][4][2], const Unit& u, int wr, int wc, int fr, int fq) const {
        const int row0 = u.pm * BM + wr * 64 + fr, col0 = u.pn * BM + wc * 32 + 8 * fq;
        if (u.pn < 22) {
#pragma unroll
            for (int ai = 0; ai < 2; ++ai)
#pragma unroll
                for (int m = 0; m < 4; ++m) { bf16_t* rowp = P + (size_t)(row0 + ai * HALF + m * 16) * NPJ + col0;
#pragma unroll
                    for (int bj = 0; bj < 2; ++bj) { const f32x4 v0 = acc[ai][bj][m][0], v1 = acc[ai][bj][m][1];
                        u32x4 w; w.x = cvt_pk_bf16(v0[0], v0[1]); w.y = cvt_pk_bf16(v0[2], v0[3]); w.z = cvt_pk_bf16(v1[0], v1[1]); w.w = cvt_pk_bf16(v1[2], v1[3]);
                        *(u32x4*)(rowp + bj * HALF) = w; } }
        } else if (wc == 0 && fq < 2) {
#pragma unroll
            for (int ai = 0; ai < 2; ++ai)
#pragma unroll
                for (int m = 0; m < 4; ++m) { float* rowp = DT + (size_t)(row0 + ai * HALF + m * 16) * H + 8 * fq;
                    *(f32x4*)(rowp) = acc[ai][0][m][0]; *(f32x4*)(rowp + 4) = acc[ai][0][m][1]; }
        }
    }
};
struct EpiRes {
    static constexpr bool PERM = false;
    const float* X; float* O;
    __device__ __forceinline__ void operator()(const f32x4 (&acc)[2][2][4][2], const Unit& u, int wr, int wc, int fr, int fq) const {
        const int row0 = u.pm * BM + wr * 64 + fr, col0 = u.pn * BM + wc * 32 + 4 * fq;
#pragma unroll
        for (int ai = 0; ai < 2; ++ai)
#pragma unroll
            for (int m = 0; m < 4; ++m) { const size_t ro = (size_t)(row0 + ai * HALF + m * 16) * D + col0;
#pragma unroll
                for (int bj = 0; bj < 2; ++bj)
#pragma unroll
                    for (int n = 0; n < 2; ++n) { const f32x4 xv = *(const f32x4*)(X + ro + bj * HALF + n * 16); *(f32x4*)(O + ro + bj * HALF + n * 16) = acc[ai][bj][m][n] + xv; } }
    }
};
struct EpiGU {
    static constexpr bool PERM = true;
    bf16_t* ACT; const float* bias; const LAS int* poff;
    __device__ __forceinline__ float act1(float g, float up) const { g = fminf(g, 7.f); up = fminf(fmaxf(up, -7.f), 7.f); return g * (1.f / (1.f + __expf(-1.702f * g))) * (up + 1.f); }
    __device__ __forceinline__ void operator()(const f32x4 (&acc)[2][2][4][2], const Unit& u, int wr, int wc, int fr, int fq) const {
        const int row0 = poff[u.e] + u.pm * BM + wr * 64 + fr, col0 = u.pn * BM + wc * 32 + 8 * fq;
        const float* bp = bias + (size_t)u.e * (2 * DFF) + col0;
        f32x4 bv[2][2];
#pragma unroll
        for (int bj = 0; bj < 2; ++bj)
#pragma unroll
            for (int n = 0; n < 2; ++n) bv[bj][n] = *(const f32x4*)(bp + bj * HALF + 4 * n);
#pragma unroll
        for (int ai = 0; ai < 2; ++ai)
#pragma unroll
            for (int m = 0; m < 4; ++m) { bf16_t* rowp = ACT + (size_t)(row0 + ai * HALF + m * 16) * DFF + (col0 >> 1);
#pragma unroll
                for (int bj = 0; bj < 2; ++bj) { const f32x4 v0 = acc[ai][bj][m][0] + bv[bj][0], v1 = acc[ai][bj][m][1] + bv[bj][1];
                    u32x2 w; w.x = cvt_pk_bf16(act1(v0[0], v0[1]), act1(v0[2], v0[3])); w.y = cvt_pk_bf16(act1(v1[0], v1[1]), act1(v1[2], v1[3]));
                    *(u32x2*)(rowp + bj * (HALF / 2)) = w; } }
    }
};
struct EpiDown {
    static constexpr bool PERM = true;
    bf16_t* YS; const float* bias; const LAS int* poff;
    __device__ __forceinline__ void operator()(const f32x4 (&acc)[2][2][4][2], const Unit& u, int wr, int wc, int fr, int fq) const {
        const int row0 = poff[u.e] + u.pm * BM + wr * 64 + fr, col0 = u.pn * BM + wc * 32 + 8 * fq;
        const float* bp = bias + (size_t)u.e * D + col0;
        f32x4 bv[2][2];
#pragma unroll
        for (int bj = 0; bj < 2; ++bj)
#pragma unroll
            for (int n = 0; n < 2; ++n) bv[bj][n] = *(const f32x4*)(bp + bj * HALF + 4 * n);
#pragma unroll
        for (int ai = 0; ai < 2; ++ai)
#pragma unroll
            for (int m = 0; m < 4; ++m) { bf16_t* rowp = YS + (size_t)(row0 + ai * HALF + m * 16) * D + col0;
#pragma unroll
                for (int bj = 0; bj < 2; ++bj) { const f32x4 v0 = acc[ai][bj][m][0] + bv[bj][0], v1 = acc[ai][bj][m][1] + bv[bj][1];
                    u32x4 w; w.x = cvt_pk_bf16(v0[0], v0[1]); w.y = cvt_pk_bf16(v0[2], v0[3]); w.z = cvt_pk_bf16(v1[0], v1[1]); w.w = cvt_pk_bf16(v1[2], v1[3]);
                    *(u32x4*)(rowp + bj * HALF) = w; } }
    }
};

template <class Epi, class Sched>
__device__ __forceinline__ void gemm_phase(LAS unsigned char* lds, const Sched& S, const Epi& E) {
    const int tid = threadIdx.x, wid = __builtin_amdgcn_readfirstlane(tid >> 6), lane = tid & 63, wr = wid >> 2, wc = wid & 3, fr = lane & 15, fq = lane >> 4;
    unsigned natA[2], voffB[2];
#pragma unroll
    for (int i = 0; i < 2; ++i) { int R, C; stage_rc(tid * 16 + i * 8192, R, C); const int Rb = Epi::PERM ? ((R & ~31) + perm32(R & 31)) : R;
        natA[i] = (unsigned)(R * K + C) * 2u; voffB[i] = (unsigned)(Rb * K + C) * 2u; }
    const size_t kstep = (size_t)(BK * 2);
    const unsigned ldsw = (unsigned)wid * 1024u;
    const int aoff = lds_byte(wr * 64 + fr, fq * 8), boff = lds_byte(wc * 32 + fr, fq * 8);
#define PG8_SA(b, h) (((b) * 2 + (h)) * HTB)
#define PG8_SB(b, h) ((4 + (b) * 2 + (h)) * HTB)
#define PG8_STAGE_A(bufoff, gbase, h) do { _Pragma("unroll") for (int _i = 0; _i < 2; ++_i) \
        __builtin_amdgcn_global_load_lds((const unsigned*)((const char*)(gbase) + va[(h) * 2 + _i]), (LAS unsigned*)(lds + (bufoff) + ldsw + _i * 8192), 16, 0, 0); } while (0)
#define PG8_STAGE_B(bufoff, gbase) do { _Pragma("unroll") for (int _i = 0; _i < 2; ++_i) \
        __builtin_amdgcn_global_load_lds((const unsigned*)((const char*)(gbase) + voffB[_i]), (LAS unsigned*)(lds + (bufoff) + ldsw + _i * 8192), 16, 0, 0); } while (0)
#define PG8_LDA(dst, b, h) do { _Pragma("unroll") for (int m = 0; m < 4; ++m) _Pragma("unroll") for (int k = 0; k < 2; ++k) dst[m][k] = *(const LAS bf16x8*)(lds + PG8_SA(b, h) + aoff + m * 2048 + k * 1024); } while (0)
#define PG8_LDB(dst, b, h) do { _Pragma("unroll") for (int n = 0; n < 2; ++n) _Pragma("unroll") for (int k = 0; k < 2; ++k) dst[n][k] = *(const LAS bf16x8*)(lds + PG8_SB(b, h) + boff + n * 2048 + k * 1024); } while (0)
#define PG8_MMA(ai, bj, At, Bt) do { __builtin_amdgcn_s_setprio(1); _Pragma("unroll") for (int m = 0; m < 4; ++m) _Pragma("unroll") for (int n = 0; n < 2; ++n) _Pragma("unroll") for (int k = 0; k < 2; ++k) \
        acc[ai][bj][m][n] = __builtin_amdgcn_mfma_f32_16x16x32_bf16(Bt[n][k], At[m][k], acc[ai][bj][m][n], 0, 0, 0); __builtin_amdgcn_s_setprio(0); } while (0)
#define PG8_WAIT_V(n) asm volatile("s_waitcnt vmcnt(" #n ")" ::: "memory")
#define PG8_WAIT_L(n) asm volatile("s_waitcnt lgkmcnt(" #n ")" ::: "memory")
#define PG8_BAR __builtin_amdgcn_s_barrier()
#define PG8_SCHED __builtin_amdgcn_sched_barrier(0)
    Unit cur, nxt; int ui = 0;
    if (!S.next(0, cur)) return;
    f32x4 acc[2][2][4][2];
#pragma unroll
    for (int a = 0; a < 2; ++a)
#pragma unroll
        for (int b = 0; b < 2; ++b)
#pragma unroll
            for (int m = 0; m < 4; ++m)
#pragma unroll
                for (int n = 0; n < 2; ++n) acc[a][b][m][n] = (f32x4){0.f, 0.f, 0.f, 0.f};
    bf16x8 At[4][2], B0[2][2], B1[2][2];
    unsigned va[4]; S.a_offs(cur, natA, va);
    const char* cA = S.a_base(cur); const char* cB = S.b_base(cur);
    PG8_STAGE_B(PG8_SB(0, 0), cB); PG8_STAGE_B(PG8_SB(0, 1), cB + HSTEP); PG8_STAGE_A(PG8_SA(0, 0), cA, 0); PG8_STAGE_A(PG8_SA(0, 1), cA, 1);
    if (wr == 1) PG8_BAR;
    PG8_WAIT_V(2); PG8_BAR;
    PG8_STAGE_B(PG8_SB(1, 0), cB + kstep); PG8_STAGE_A(PG8_SA(1, 0), cA + kstep, 0); PG8_STAGE_B(PG8_SB(1, 1), cB + HSTEP + kstep);
    PG8_WAIT_V(6); PG8_BAR;
    for (;;) {
        const bool has_next = S.next(ui + 1, nxt);
        const char* nA = has_next ? S.a_base(nxt) : cA; const char* nB = has_next ? S.b_base(nxt) : cB;
        for (int t = 0; t < NTK; t += 2) {
            const bool last = (t == NTK - 2);
            const char* a1 = cA + (size_t)(t + 1) * kstep;
            const char* a2 = last ? nA : cA + (size_t)(t + 2) * kstep; const char* b2 = last ? nB : cB + (size_t)(t + 2) * kstep;
            const char* a3 = a2 + kstep; const char* b3 = b2 + kstep;
            unsigned vn[4] = {va[0], va[1], va[2], va[3]};
            if (last && has_next) S.a_offs(nxt, natA, vn);
            PG8_LDB(B0, 0, 0); PG8_LDB(B1, 0, 1); PG8_SCHED; PG8_LDA(At, 0, 0); PG8_STAGE_A(PG8_SA(1, 1), a1, 1);
            PG8_WAIT_V(8); PG8_WAIT_L(0); PG8_BAR; PG8_MMA(0, 0, At, B0); PG8_MMA(0, 1, At, B1); PG8_BAR; PG8_SCHED;
            if (last) { va[0] = vn[0]; va[1] = vn[1]; va[2] = vn[2]; va[3] = vn[3]; }
            PG8_LDA(At, 0, 1); PG8_STAGE_B(PG8_SB(0, 0), b2); PG8_STAGE_B(PG8_SB(0, 1), b2 + HSTEP); PG8_STAGE_A(PG8_SA(0, 0), a2, 0);
            PG8_WAIT_V(8); PG8_WAIT_L(0); PG8_BAR; PG8_MMA(1, 0, At, B0); PG8_MMA(1, 1, At, B1); PG8_BAR; PG8_SCHED;
            PG8_LDB(B0, 1, 0); PG8_LDB(B1, 1, 1); PG8_SCHED; PG8_LDA(At, 1, 0); PG8_STAGE_A(PG8_SA(0, 1), a2, 1);
            PG8_WAIT_V(8); PG8_WAIT_L(0); PG8_BAR; PG8_MMA(0, 0, At, B0); PG8_MMA(0, 1, At, B1); PG8_BAR; PG8_SCHED;
            PG8_LDA(At, 1, 1); PG8_STAGE_B(PG8_SB(1, 0), b3); PG8_STAGE_B(PG8_SB(1, 1), b3 + HSTEP); PG8_STAGE_A(PG8_SA(1, 0), a3, 0);
            PG8_WAIT_V(8); PG8_WAIT_L(0); PG8_BAR; PG8_MMA(1, 0, At, B0); PG8_MMA(1, 1, At, B1); PG8_BAR; PG8_SCHED;
        }
        if (wr == 0) PG8_BAR;
        E(acc, cur, wr, wc, fr, fq);
        if (!has_next) break;
#pragma unroll
        for (int a = 0; a < 2; ++a)
#pragma unroll
            for (int b = 0; b < 2; ++b)
#pragma unroll
                for (int m = 0; m < 4; ++m)
#pragma unroll
                    for (int n = 0; n < 2; ++n) acc[a][b][m][n] = (f32x4){0.f, 0.f, 0.f, 0.f};
        cur = nxt; cA = nA; cB = nB; ++ui;
        if (wr == 1) PG8_BAR;
    }
    PG8_WAIT_V(0);
    PG8_BAR;
#undef PG8_SA
#undef PG8_SB
#undef PG8_STAGE_A
#undef PG8_STAGE_B
#undef PG8_LDA
#undef PG8_LDB
#undef PG8_MMA
#undef PG8_WAIT_V
#undef PG8_WAIT_L
#undef PG8_BAR
#undef PG8_SCHED
}
}

struct Args { const float* in[18]; float* out; unsigned char* ws; int ph_lo, ph_hi; };
struct Frame { LAS unsigned char* lds; int tid, lane, wave, vcu, G; };

__device__ __forceinline__ void transpose_item(const float* W, int ldw, int nvalid, bf16_t* WT, LAS float* scr, int kb, int nb, int lane) {
    const int k0 = 64 * kb, n0 = 32 * nb, nn = n0 + (lane & 31); const bool ok = nn < nvalid;
    const float* src = W + (size_t)(k0 + (lane >> 5)) * ldw + (ok ? nn : 0);
    float v[32];
#pragma unroll
    for (int i = 0; i < 32; ++i) v[i] = src[(size_t)(2 * i) * ldw];
#pragma unroll
    for (int i = 0; i < 32; ++i) scr[(2 * i + (lane >> 5)) * 33 + (lane & 31)] = ok ? v[i] : 0.f;
    LDS_WAIT(); asm volatile("" ::: "memory");
    const int c = lane & 7;
#pragma unroll
    for (int j = 0; j < 4; ++j) { const int n = (lane >> 3) + 8 * j; const LAS float* s = scr + (8 * c) * 33 + n;
        u32x4 o; o.x = cvt_pk_bf16(s[0 * 33], s[1 * 33]); o.y = cvt_pk_bf16(s[2 * 33], s[3 * 33]); o.z = cvt_pk_bf16(s[4 * 33], s[5 * 33]); o.w = cvt_pk_bf16(s[6 * 33], s[7 * 33]);
        *(u32x4*)(WT + (size_t)(n0 + n) * 2048 + k0 + 8 * c) = o; }
    LDS_WAIT(); asm volatile("" ::: "memory");
}
__device__ __forceinline__ float rms_load(const float* xrow, int lane, f32x4 (&v)[8]) {
    const f32x4* xr = (const f32x4*)xrow + lane; float s = 0.f;
#pragma unroll
    for (int j = 0; j < 8; ++j) { v[j] = xr[64 * j]; s += (v[j].x * v[j].x + v[j].y * v[j].y) + (v[j].z * v[j].z + v[j].w * v[j].w); }
    return rsqrtf(wave_sum(s) * (1.f / D) + EPS);
}

__device__ __forceinline__ void p0_prologue(const Frame& F, const Args& a) {
    LAS float* scr = (LAS float*)(F.lds + F.wave * 16384);
    const int gw = F.vcu * NWAVES + F.wave, NGW = F.G * NWAVES;
    const float* x = a.in[0]; const float* g_mix = a.in[1]; const float* w_in = a.in[2]; const float* w_out = a.in[9]; const float* w_gu = a.in[13]; const float* w_dn = a.in[15];
    bf16_t* WinT = (bf16_t*)(a.ws + WS_WIN); bf16_t* WoutT = (bf16_t*)(a.ws + WS_WOUT); bf16_t* WguT = (bf16_t*)(a.ws + WS_WGU); bf16_t* WdnT = (bf16_t*)(a.ws + WS_WDN); bf16_t* XN = (bf16_t*)(a.ws + WS_XN);
    for (int m = gw; m < S; m += NGW) { f32x4 v[8]; const float r = rms_load(x + (size_t)m * D, F.lane, v);
        const f32x4* gp = (const f32x4*)g_mix + F.lane; u32x2* o8 = (u32x2*)(XN + (size_t)m * D) + F.lane;
#pragma unroll
        for (int j = 0; j < 8; ++j) { const f32x4 g = gp[64 * j]; u32x2 w; w.x = cvt_pk_bf16(v[j].x * r * g.x, v[j].y * r * g.y); w.y = cvt_pk_bf16(v[j].z * r * g.z, v[j].w * r * g.w); o8[64 * j] = w; } }
    constexpr int I_IN = 32 * (NPAD / 32), I_OUT = 32 * (D / 32), I_GU = 32 * (2 * DFF / 32), I_DN = 32 * (D / 32);
    constexpr int NITEMS = I_IN + I_OUT + NE * I_GU + NE * I_DN;
    for (int it = gw; it < NITEMS; it += NGW) {
        int r = it;
        if (r < I_IN) { transpose_item(w_in, NPROJ, NPROJ, WinT, scr, r / (NPAD / 32), r % (NPAD / 32), F.lane); continue; } r -= I_IN;
        if (r < I_OUT) { transpose_item(w_out, D, D, WoutT, scr, r / (D / 32), r % (D / 32), F.lane); continue; } r -= I_OUT;
        if (r < NE * I_GU) { const int e = r / I_GU, q = r % I_GU; transpose_item(w_gu + (size_t)e * D * 2 * DFF, 2 * DFF, 2 * DFF, WguT + (size_t)e * 2 * DFF * D, scr, q / (2 * DFF / 32), q % (2 * DFF / 32), F.lane); continue; } r -= NE * I_GU;
        { const int e = r / I_DN, q = r % I_DN; transpose_item(w_dn + (size_t)e * DFF * D, D, D, WdnT + (size_t)e * D * DFF, scr, q / (D / 32), q % (D / 32), F.lane); }
    }
}

constexpr int XS_STRIDE = 1024 + 16, BS_STRIDE = 256 + 16;
constexpr int L_XS = 0, L_BS = 64 * XS_STRIDE, L_CS = L_BS + 64 * BS_STRIDE, L_WV = L_CS + 64 * BS_STRIDE;
static_assert(L_WV + 8 * 768 <= RING_BYTES, "ssd lds");
__device__ __forceinline__ void tr_read2(unsigned a0, unsigned a1, u32x2& r0, u32x2& r1) {
    asm volatile("ds_read_b64_tr_b16 %0, %2\n\tds_read_b64_tr_b16 %1, %3\n\ts_waitcnt lgkmcnt(0)" : "=&v"(r0), "=&v"(r1) : "v"(a0), "v"(a1) : "memory");
}
__device__ __forceinline__ bf16x8 mk_frag(u32x2 lo, u32x2 hi) { u32x4 v; v.x = lo.x; v.y = lo.y; v.z = hi.x; v.w = hi.y; return __builtin_bit_cast(bf16x8, v); }
__device__ __forceinline__ float silu_fast(float x) { return x * __builtin_amdgcn_rcpf(1.f + __expf(-x)); }

__device__ __forceinline__ void ssd_a_unit(const Frame& F, const Args& a, int c, int g) {
    const bf16_t* PROJ = (const bf16_t*)(a.ws + WS_PROJ); const float* DT = (const float*)(a.ws + WS_DT);
    float* ACUM = (float*)(a.ws + WS_ACUM); float* DEC = (float*)(a.ws + WS_DEC); bf16_t* CC = (bf16_t*)(a.ws + WS_CC); float* Y0 = (float*)(a.ws + WS_Y0); bf16_t* SC = (bf16_t*)(a.ws + WS_SC);
    const float* cw = a.in[3]; const float* cb = a.in[4];
    int tid = F.tid; asm volatile("" : "+v"(tid));
    const int t0 = c * CL, lane = tid & 63, w = F.wave, h = g * 8 + w;
    LAS unsigned char* lds = F.lds;
    if (tid < 384) {
        const int cg = tid % 96, tr = tid / 96;
        int ch, dstride; LAS unsigned char* dst;
        if (cg < 64) { ch = g * 512 + cg * 8; dst = lds + L_XS + cg * 16; dstride = XS_STRIDE; }
        else if (cg < 80) { ch = 1024 + g * 128 + (cg - 64) * 8; dst = lds + L_BS + (cg - 64) * 16; dstride = BS_STRIDE; }
        else { ch = 1280 + g * 128 + (cg - 80) * 8; dst = lds + L_CS + (cg - 80) * 16; dstride = BS_STRIDE; }
        float wt[4][8], bs[8];
#pragma unroll
        for (int k = 0; k < 4; ++k) { const f32x4 w0 = *(const f32x4*)(cw + k * XBC + ch), w1 = *(const f32x4*)(cw + k * XBC + ch + 4);
            wt[k][0] = w0.x; wt[k][1] = w0.y; wt[k][2] = w0.z; wt[k][3] = w0.w; wt[k][4] = w1.x; wt[k][5] = w1.y; wt[k][6] = w1.z; wt[k][7] = w1.w; }
        { const f32x4 b0 = *(const f32x4*)(cb + ch), b1 = *(const f32x4*)(cb + ch + 4); bs[0] = b0.x; bs[1] = b0.y; bs[2] = b0.z; bs[3] = b0.w; bs[4] = b1.x; bs[5] = b1.y; bs[6] = b1.z; bs[7] = b1.w; }
        const int tb = t0 + tr * 16;
        u32x4 rows[19];
#pragma unroll
        for (int i = 0; i < 19; ++i) { const int tt = tb - 3 + i; rows[i] = (u32x4){0u, 0u, 0u, 0u}; if (tt >= 0) rows[i] = *(const u32x4*)(PROJ + (size_t)tt * NPJ + C_XBC + ch); }
#pragma unroll
        for (int i = 0; i < 16; ++i) {
            float acc[8];
#pragma unroll
            for (int j = 0; j < 8; ++j) acc[j] = bs[j];
#pragma unroll
            for (int k = 0; k < 4; ++k) { const u32x4 xv = rows[i + k];
                acc[0] = fmaf(wt[k][0], bf_lo(xv.x), acc[0]); acc[1] = fmaf(wt[k][1], bf_hi(xv.x), acc[1]); acc[2] = fmaf(wt[k][2], bf_lo(xv.y), acc[2]); acc[3] = fmaf(wt[k][3], bf_hi(xv.y), acc[3]);
                acc[4] = fmaf(wt[k][4], bf_lo(xv.z), acc[4]); acc[5] = fmaf(wt[k][5], bf_hi(xv.z), acc[5]); acc[6] = fmaf(wt[k][6], bf_lo(xv.w), acc[6]); acc[7] = fmaf(wt[k][7], bf_hi(xv.w), acc[7]); }
            u32x4 o; o.x = cvt_pk_bf16(silu_fast(acc[0]), silu_fast(acc[1])); o.y = cvt_pk_bf16(silu_fast(acc[2]), silu_fast(acc[3])); o.z = cvt_pk_bf16(silu_fast(acc[4]), silu_fast(acc[5])); o.w = cvt_pk_bf16(silu_fast(acc[6]), silu_fast(acc[7]));
            *(LAS u32x4*)(dst + (tr * 16 + i) * dstride) = o;
            if (cg >= 80) *(u32x4*)(CC + (size_t)(tb + i) * 256 + g * 128 + (cg - 80) * 8) = o;
        }
    }
    __syncthreads();
    const int fr = lane & 15, fq = lane >> 4;
    LAS float* wv = (LAS float*)(lds + L_WV + w * 768);
    const float Ah = -expf(a.in[6][h]), Dh = a.in[7][h];
    {
        const float dtv = softplus_acc(DT[(size_t)(t0 + lane) * H + h] + a.in[5][h]);
        float ac = dtv * Ah;
#pragma unroll
        for (int o = 1; o < 64; o <<= 1) { const float n = __shfl_up(ac, o); if (lane >= o) ac += n; }
        const float atot = __shfl(ac, 63);
        wv[lane] = ac; wv[64 + lane] = dtv; wv[128 + lane] = dtv * __expf(atot - ac);
        ACUM[(size_t)(t0 + lane) * H + h] = ac; if (lane == 0) DEC[c * H + h] = __expf(atot);
    }
    LDS_WAIT();
    const unsigned lbase = (unsigned)(uintptr_t)lds;
    f32x4 cbt[4][4];
#pragma unroll
    for (int i = 0; i < 4; ++i)
#pragma unroll
        for (int j = 0; j < 4; ++j) cbt[i][j] = (f32x4){0.f, 0.f, 0.f, 0.f};
#pragma unroll
    for (int kk = 0; kk < 4; ++kk) { bf16x8 af[4], bfr[4];
#pragma unroll
        for (int i = 0; i < 4; ++i) { af[i] = *(const LAS bf16x8*)(lds + L_BS + (16 * i + fr) * BS_STRIDE + (32 * kk + 8 * fq) * 2); bfr[i] = *(const LAS bf16x8*)(lds + L_CS + (16 * i + fr) * BS_STRIDE + (32 * kk + 8 * fq) * 2); }
#pragma unroll
        for (int i = 0; i < 4; ++i)
#pragma unroll
            for (int j = 0; j < 4; ++j) cbt[i][j] = __builtin_amdgcn_mfma_f32_16x16x32_bf16(af[i], bfr[j], cbt[i][j], 0, 0, 0); }
    bf16x8 mt[4][2];
    {
        float acl[4];
#pragma unroll
        for (int j = 0; j < 4; ++j) acl[j] = wv[16 * j + fr];
#pragma unroll
        for (int u = 0; u < 2; ++u) {
            const f32x4 as0 = *(const LAS f32x4*)(wv + 32 * u + 4 * fq), as1 = *(const LAS f32x4*)(wv + 32 * u + 16 + 4 * fq);
            const f32x4 ds0 = *(const LAS f32x4*)(wv + 64 + 32 * u + 4 * fq), ds1 = *(const LAS f32x4*)(wv + 64 + 32 * u + 16 + 4 * fq);
#pragma unroll
            for (int j = 0; j < 4; ++j) { const int l = 16 * j + fr; float m0[4], m1[4];
#pragma unroll
                for (int r = 0; r < 4; ++r) { const int s0 = 32 * u + 4 * fq + r, s1 = s0 + 16;
                    m0[r] = (s0 <= l) ? cbt[2 * u][j][r] * __expf(acl[j] - as0[r]) * ds0[r] : 0.f;
                    m1[r] = (s1 <= l) ? cbt[2 * u + 1][j][r] * __expf(acl[j] - as1[r]) * ds1[r] : 0.f; }
                u32x4 pk; pk.x = cvt_pk_bf16(m0[0], m0[1]); pk.y = cvt_pk_bf16(m0[2], m0[3]); pk.z = cvt_pk_bf16(m1[0], m1[1]); pk.w = cvt_pk_bf16(m1[2], m1[3]);
                mt[j][u] = __builtin_bit_cast(bf16x8, pk); }
        }
    }
    {
        f32x4 yd[4][4];
#pragma unroll
        for (int i = 0; i < 4; ++i)
#pragma unroll
            for (int j = 0; j < 4; ++j) yd[i][j] = (f32x4){0.f, 0.f, 0.f, 0.f};
        const unsigned xa = lbase + L_XS + ((lane & 15) >> 2) * XS_STRIDE + (w * 64 + 4 * (lane & 3)) * 2;
#pragma unroll
        for (int u = 0; u < 2; ++u)
#pragma unroll
            for (int i = 0; i < 4; ++i) { u32x2 r0, r1; const unsigned ad = xa + (32 * u + 4 * fq) * XS_STRIDE + 32 * i; tr_read2(ad, ad + 16 * XS_STRIDE, r0, r1); const bf16x8 xf = mk_frag(r0, r1);
#pragma unroll
                for (int j = 0; j < 4; ++j) yd[i][j] = __builtin_amdgcn_mfma_f32_16x16x32_bf16(xf, mt[j][u], yd[i][j], 0, 0, 0); }
        float* yo = Y0 + ((size_t)(c * H + h) * 16) * 256 + lane * 4;
#pragma unroll
        for (int i = 0; i < 4; ++i)
#pragma unroll
            for (int j = 0; j < 4; ++j) { const u32x2 xv = *(const LAS u32x2*)(lds + L_XS + (16 * j + fr) * XS_STRIDE + (w * 64 + 16 * i + 4 * fq) * 2);
                f32x4 o = yd[i][j]; o.x = fmaf(Dh, bf_lo(xv.x), o.x); o.y = fmaf(Dh, bf_hi(xv.x), o.y); o.z = fmaf(Dh, bf_lo(xv.y), o.z); o.w = fmaf(Dh, bf_hi(xv.y), o.w);
                *(f32x4*)(yo + (i * 4 + j) * 256) = o; }
    }
    {
        bf16x8 xw[4][2];
        const unsigned xa = lbase + L_XS + ((lane & 15) >> 2) * XS_STRIDE + (w * 64 + 4 * (lane & 3)) * 2;
#pragma unroll
        for (int ks = 0; ks < 2; ++ks) {
            const f32x4 w0 = *(const LAS f32x4*)(wv + 128 + 32 * ks + 8 * fq), w1 = *(const LAS f32x4*)(wv + 128 + 32 * ks + 8 * fq + 4);
#pragma unroll
            for (int i = 0; i < 4; ++i) { u32x2 r0, r1; const unsigned ad = xa + (32 * ks + 8 * fq) * XS_STRIDE + 32 * i; tr_read2(ad, ad + 4 * XS_STRIDE, r0, r1);
                u32x4 pk; pk.x = cvt_pk_bf16(bf_lo(r0.x) * w0.x, bf_hi(r0.x) * w0.y); pk.y = cvt_pk_bf16(bf_lo(r0.y) * w0.z, bf_hi(r0.y) * w0.w);
                pk.z = cvt_pk_bf16(bf_lo(r1.x) * w1.x, bf_hi(r1.x) * w1.y); pk.w = cvt_pk_bf16(bf_lo(r1.y) * w1.z, bf_hi(r1.y) * w1.w);
                xw[i][ks] = __builtin_bit_cast(bf16x8, pk); }
        }
        const unsigned ba = lbase + L_BS + ((lane & 15) >> 2) * BS_STRIDE + (4 * (lane & 3)) * 2;
        u32x2* so = (u32x2*)(SC + ((size_t)(c * H + h) * 32) * 256) + lane;
#pragma unroll
        for (int nt = 0; nt < 8; ++nt) {
            f32x4 sc[4];
#pragma unroll
            for (int i = 0; i < 4; ++i) sc[i] = (f32x4){0.f, 0.f, 0.f, 0.f};
#pragma unroll
            for (int ks = 0; ks < 2; ++ks) { u32x2 r0, r1; const unsigned ad = ba + (32 * ks + 8 * fq) * BS_STRIDE + 32 * nt; tr_read2(ad, ad + 4 * BS_STRIDE, r0, r1); const bf16x8 bt = mk_frag(r0, r1);
#pragma unroll
                for (int i = 0; i < 4; ++i) sc[i] = __builtin_amdgcn_mfma_f32_16x16x32_bf16(bt, xw[i][ks], sc[i], 0, 0, 0); }
#pragma unroll
            for (int i = 0; i < 4; ++i) { u32x2 o; o.x = cvt_pk_bf16(sc[i].x, sc[i].y); o.y = cvt_pk_bf16(sc[i].z, sc[i].w); so[(nt * 4 + i) * 64] = o; }
        }
    }
    __syncthreads();
}

__device__ __forceinline__ void ssd_scan(const Frame& F, const Args& a) {
    if (F.tid >= 256) return;
    const unsigned* SC = (const unsigned*)(a.ws + WS_SC); unsigned* PV = (unsigned*)(a.ws + WS_PREV); const float* DEC = (const float*)(a.ws + WS_DEC);
    const int i = F.vcu * 256 + F.tid;
    if (i >= 65536) return;
    const int h = i >> 12;
    float c0 = 0.f, c1 = 0.f;
#pragma unroll 16
    for (int c = 0; c < NCH; ++c) {
        const unsigned sv = SC[(size_t)c * 65536 + i]; const float d = DEC[c * H + h];
        PV[(size_t)c * 65536 + i] = cvt_pk_bf16(c0, c1);
        c0 = fmaf(c0, d, bf_lo(sv)); c1 = fmaf(c1, d, bf_hi(sv));
    }
}

__device__ __forceinline__ void ssd_c_unit(const Frame& F, const Args& a, int c, int g) {
    const bf16_t* PROJ = (const bf16_t*)(a.ws + WS_PROJ); const float* ACUM = (const float*)(a.ws + WS_ACUM); const bf16_t* CC = (const bf16_t*)(a.ws + WS_CC);
    const float* Y0 = (const float*)(a.ws + WS_Y0); const bf16_t* PV = (const bf16_t*)(a.ws + WS_PREV); bf16_t* MIX = (bf16_t*)(a.ws + WS_MIX); const float* g_ssm = a.in[8];
    const int t0 = c * CL, lane = F.lane, w = F.wave, h = g * 8 + w, fr = lane & 15, fq = lane >> 4;
    LAS float* red = (LAS float*)(F.lds);
    f32x4 yo[4][4];
#pragma unroll
    for (int i = 0; i < 4; ++i)
#pragma unroll
        for (int j = 0; j < 4; ++j) yo[i][j] = (f32x4){0.f, 0.f, 0.f, 0.f};
    const u32x2* pv = (const u32x2*)(PV + ((size_t)(c * H + h) * 32) * 256) + lane;
#pragma unroll
    for (int u = 0; u < 4; ++u) { bf16x8 pf[4], cf[4];
#pragma unroll
        for (int i = 0; i < 4; ++i) pf[i] = mk_frag(pv[((2 * u) * 4 + i) * 64], pv[((2 * u + 1) * 4 + i) * 64]);
#pragma unroll
        for (int j = 0; j < 4; ++j) { const bf16_t* cp = CC + (size_t)(t0 + 16 * j + fr) * 256 + g * 128 + 32 * u + 4 * fq; cf[j] = mk_frag(*(const u32x2*)cp, *(const u32x2*)(cp + 16)); }
#pragma unroll
        for (int i = 0; i < 4; ++i)
#pragma unroll
            for (int j = 0; j < 4; ++j) yo[i][j] = __builtin_amdgcn_mfma_f32_16x16x32_bf16(pf[i], cf[j], yo[i][j], 0, 0, 0); }
    const float* y0 = Y0 + ((size_t)(c * H + h) * 16) * 256 + lane * 4;
    float ssq[4];
#pragma unroll
    for (int j = 0; j < 4; ++j) { const int t = t0 + 16 * j + fr; const float ea = __expf(ACUM[(size_t)t * H + h]); float sq = 0.f;
#pragma unroll
        for (int i = 0; i < 4; ++i) { const f32x4 b = *(const f32x4*)(y0 + (i * 4 + j) * 256); const u32x2 zv = *(const u32x2*)(PROJ + (size_t)t * NPJ + C_Z + h * HD + 16 * i + 4 * fq);
            f32x4 y; y.x = fmaf(ea, yo[i][j].x, b.x) * silu_fast(bf_lo(zv.x)); y.y = fmaf(ea, yo[i][j].y, b.y) * silu_fast(bf_hi(zv.x)); y.z = fmaf(ea, yo[i][j].z, b.z) * silu_fast(bf_lo(zv.y)); y.w = fmaf(ea, yo[i][j].w, b.w) * silu_fast(bf_hi(zv.y));
            yo[i][j] = y; sq += (y.x * y.x + y.y * y.y) + (y.z * y.z + y.w * y.w); }
        sq += __shfl_xor(sq, 16); sq += __shfl_xor(sq, 32); ssq[j] = sq; }
    if (fq == 0) {
#pragma unroll
        for (int j = 0; j < 4; ++j) red[(16 * j + fr) * 8 + w] = ssq[j]; }
    __syncthreads();
#pragma unroll
    for (int j = 0; j < 4; ++j) { const f32x4 r0 = *(const LAS f32x4*)(red + (16 * j + fr) * 8), r1 = *(const LAS f32x4*)(red + (16 * j + fr) * 8 + 4);
        const float tot = ((r0.x + r0.y) + (r0.z + r0.w)) + ((r1.x + r1.y) + (r1.z + r1.w)); const float rs = rsqrtf(tot * (1.f / 512.f) + EPS);
        const int t = t0 + 16 * j + fr;
#pragma unroll
        for (int i = 0; i < 4; ++i) { const int col = h * HD + 16 * i + 4 * fq; const f32x4 gs = *(const f32x4*)(g_ssm + col); const f32x4 y = yo[i][j];
            u32x2 o; o.x = cvt_pk_bf16(y.x * rs * gs.x, y.y * rs * gs.y); o.y = cvt_pk_bf16(y.z * rs * gs.z, y.w * rs * gs.w);
            *(u32x2*)(MIX + (size_t)t * D + 1024 + col) = o; } }
    __syncthreads();
}

__device__ __forceinline__ void attn_unit(const Args& a, int h, int t0, int lane) {
    const bf16_t* PROJ = (const bf16_t*)(a.ws + WS_PROJ); bf16_t* MIX = (bf16_t*)(a.ws + WS_MIX);
    const int t = t0 + lane;
    float q[64], o[64];
    { const u32x4* qp = (const u32x4*)(PROJ + (size_t)t * NPJ + h * HD);
#pragma unroll
        for (int i = 0; i < 8; ++i) { const u32x4 u = qp[i]; q[8 * i + 0] = bf_lo(u.x) * 0.125f; q[8 * i + 1] = bf_hi(u.x) * 0.125f; q[8 * i + 2] = bf_lo(u.y) * 0.125f; q[8 * i + 3] = bf_hi(u.y) * 0.125f;
            q[8 * i + 4] = bf_lo(u.z) * 0.125f; q[8 * i + 5] = bf_hi(u.z) * 0.125f; q[8 * i + 6] = bf_lo(u.w) * 0.125f; q[8 * i + 7] = bf_hi(u.w) * 0.125f; } }
#pragma unroll
    for (int d = 0; d < 64; ++d) o[d] = 0.f;
    float carry = 0.f;
    for (int s = t0 + 62; s >= 0; --s) {
        const u32x4* kp = (const u32x4*)(PROJ + (size_t)s * NPJ + C_K + h * HD); const u32x4* vp = (const u32x4*)(PROJ + (size_t)s * NPJ + C_V + h * HD);
        float l = 0.f;
#pragma unroll
        for (int i = 0; i < 8; ++i) { const u32x4 u = kp[i]; l = fmaf(q[8 * i + 0], bf_lo(u.x), l); l = fmaf(q[8 * i + 1], bf_hi(u.x), l); l = fmaf(q[8 * i + 2], bf_lo(u.y), l); l = fmaf(q[8 * i + 3], bf_hi(u.y), l);
            l = fmaf(q[8 * i + 4], bf_lo(u.z), l); l = fmaf(q[8 * i + 5], bf_hi(u.z), l); l = fmaf(q[8 * i + 6], bf_lo(u.w), l); l = fmaf(q[8 * i + 7], bf_hi(u.w), l); }
        const bool act = s < t;
        const float lk = -(fmaxf(l, 0.f) + __logf(1.f + __expf(-fabsf(l))));
        const float w = act ? __expf(l + lk + carry) : 0.f;
        carry += act ? lk : 0.f;
#pragma unroll
        for (int i = 0; i < 8; ++i) { const u32x4 u = vp[i]; o[8 * i + 0] = fmaf(w, bf_lo(u.x), o[8 * i + 0]); o[8 * i + 1] = fmaf(w, bf_hi(u.x), o[8 * i + 1]); o[8 * i + 2] = fmaf(w, bf_lo(u.y), o[8 * i + 2]); o[8 * i + 3] = fmaf(w, bf_hi(u.y), o[8 * i + 3]);
            o[8 * i + 4] = fmaf(w, bf_lo(u.z), o[8 * i + 4]); o[8 * i + 5] = fmaf(w, bf_hi(u.z), o[8 * i + 5]); o[8 * i + 6] = fmaf(w, bf_lo(u.w), o[8 * i + 6]); o[8 * i + 7] = fmaf(w, bf_hi(u.w), o[8 * i + 7]); }
        if (__all(carry < -104.f)) break;
    }
    u32x4* op = (u32x4*)(MIX + (size_t)t * D + h * HD);
#pragma unroll
    for (int i = 0; i < 8; ++i) { u32x4 w; w.x = cvt_pk_bf16(o[8 * i + 0], o[8 * i + 1]); w.y = cvt_pk_bf16(o[8 * i + 2], o[8 * i + 3]); w.z = cvt_pk_bf16(o[8 * i + 4], o[8 * i + 5]); w.w = cvt_pk_bf16(o[8 * i + 6], o[8 * i + 7]); op[i] = w; }
}

__device__ __forceinline__ void p2_mix(const Frame& F, const Args& a) {
    unsigned* ctl = (unsigned*)(a.ws + WS_CTL);
    for (int u = F.vcu; u < NCH * 2; u += F.G) ssd_a_unit(F, a, u >> 1, u & 1);
    for (;;) {
        int u = 0; if (F.lane == 0) u = (int)__hip_atomic_fetch_add(ctl + CW_ATTQ, 1u, RLX_AGENT);
        u = __builtin_amdgcn_readfirstlane(u);
        if (u >= H * (S / 64)) break;
        const int blk = (S / 64 - 1) - (u / H), h = u % H;
        attn_unit(a, h, blk * 64, F.lane);
    }
}

__device__ __forceinline__ void p6_router(const Frame& F, const Args& a) {
    const float* X2 = (const float*)(a.ws + WS_X2); bf16_t* H2 = (bf16_t*)(a.ws + WS_H2); const float* g_ffn = a.in[10]; const float* wr = a.in[11]; const float* br = a.in[12];
    unsigned* cnt = (unsigned*)(a.ws + WS_CTL) + CW_CNT; int* tokof = (int*)(a.ws + WS_TOKOF); int* TE = (int*)(a.ws + WS_TE); int* TP = (int*)(a.ws + WS_TP); float* TG = (float*)(a.ws + WS_TG);
    const int gw = F.vcu * NWAVES + F.wave, NGW = F.G * NWAVES;
    for (int t = gw; t < S; t += NGW) {
        f32x4 v[8]; const float r = rms_load(X2 + (size_t)t * D, F.lane, v);
        const f32x4* gp = (const f32x4*)g_ffn + F.lane; u32x2* o8 = (u32x2*)(H2 + (size_t)t * D) + F.lane;
        float lg[32];
#pragma unroll
        for (int e = 0; e < 32; ++e) lg[e] = 0.f;
#pragma unroll
        for (int j = 0; j < 8; ++j) { const f32x4 g = gp[64 * j]; v[j].x *= r * g.x; v[j].y *= r * g.y; v[j].z *= r * g.z; v[j].w *= r * g.w;
            u32x2 w; w.x = cvt_pk_bf16(v[j].x, v[j].y); w.y = cvt_pk_bf16(v[j].z, v[j].w); o8[64 * j] = w;
            const float hv[4] = {v[j].x, v[j].y, v[j].z, v[j].w};
#pragma unroll
            for (int i = 0; i < 4; ++i) { const f32x4* wp = (const f32x4*)(wr + (size_t)(4 * F.lane + 256 * j + i) * NE);
#pragma unroll
                for (int e4 = 0; e4 < 8; ++e4) { const f32x4 w4 = wp[e4]; lg[4 * e4 + 0] = fmaf(hv[i], w4.x, lg[4 * e4 + 0]); lg[4 * e4 + 1] = fmaf(hv[i], w4.y, lg[4 * e4 + 1]); lg[4 * e4 + 2] = fmaf(hv[i], w4.z, lg[4 * e4 + 2]); lg[4 * e4 + 3] = fmaf(hv[i], w4.w, lg[4 * e4 + 3]); } } }
#pragma unroll
        for (int e = 0; e < 32; ++e) lg[e] = wave_sum(lg[e]) + br[e];
        int sel[4]; float sv[4];
#pragma unroll
        for (int k = 0; k < 4; ++k) { float bv = -3.4e38f; int bi = 0;
#pragma unroll
            for (int e = 0; e < 32; ++e) { const bool gt = lg[e] > bv; bv = gt ? lg[e] : bv; bi = gt ? e : bi; }
#pragma unroll
            for (int e = 0; e < 32; ++e) lg[e] = (e == bi) ? -3.4e38f : lg[e];
            sel[k] = bi; sv[k] = bv; }
        const float e1 = expf(sv[1] - sv[0]), e2 = expf(sv[2] - sv[0]), e3 = expf(sv[3] - sv[0]); const float inv = 1.f / (1.f + e1 + e2 + e3);
        if (F.lane < 4) { const int me = F.lane == 0 ? sel[0] : F.lane == 1 ? sel[1] : F.lane == 2 ? sel[2] : sel[3]; const float mg = (F.lane == 0 ? 1.f : F.lane == 1 ? e1 : F.lane == 2 ? e2 : e3) * inv;
            const int pos = (int)__hip_atomic_fetch_add(cnt + me, 1u, RLX_AGENT);
            tokof[me * ECAP + pos] = t; TE[t * 4 + F.lane] = me; TP[t * 4 + F.lane] = pos; TG[t * 4 + F.lane] = mg; }
    }
}

__device__ __forceinline__ void moe_tables(const Frame& F, const Args& a, int ntn) {
    LAS int* T = (LAS int*)(F.lds + LDSCTL_OFF);
    unsigned* cnt = (unsigned*)(a.ws + WS_CTL) + CW_CNT;
    __syncthreads();
    if (F.tid == 0) { int pu = 0, po = 0;
        for (int e = 0; e < NE; ++e) { const int c = (int)__hip_atomic_load(cnt + e, RLX_AGENT); const int mt = (c + 255) >> 8; T[L_CNT + e] = c; T[L_PFXU + e] = pu; T[L_POFF + e] = po; pu += mt * ntn; po += mt * 256; }
        T[L_PFXU + NE] = pu; T[L_POFF + NE] = po; }
    __syncthreads();
}

__device__ __forceinline__ void p9_final(const Frame& F, const Args& a) {
    const float* X2 = (const float*)(a.ws + WS_X2); const bf16_t* YS = (const bf16_t*)(a.ws + WS_YS); const int* TE = (const int*)(a.ws + WS_TE); const int* TP = (const int*)(a.ws + WS_TP); const float* TG = (const float*)(a.ws + WS_TG);
    const float* g_final = a.in[17]; const LAS int* T = (const LAS int*)(F.lds + LDSCTL_OFF);
    const int gw = F.vcu * NWAVES + F.wave, NGW = F.G * NWAVES;
    for (int t = gw; t < S; t += NGW) {
        f32x4 v[8]; const f32x4* xr = (const f32x4*)(X2 + (size_t)t * D) + F.lane;
#pragma unroll
        for (int j = 0; j < 8; ++j) v[j] = xr[64 * j];
#pragma unroll
        for (int k = 0; k < 4; ++k) { const int e = TE[t * 4 + k], pos = TP[t * 4 + k]; const float g = TG[t * 4 + k];
            const u32x2* yp = (const u32x2*)(YS + (size_t)(T[L_POFF + e] + pos) * D) + F.lane;
#pragma unroll
            for (int j = 0; j < 8; ++j) { const u32x2 y = yp[64 * j]; v[j].x = fmaf(g, bf_lo(y.x), v[j].x); v[j].y = fmaf(g, bf_hi(y.x), v[j].y); v[j].z = fmaf(g, bf_lo(y.y), v[j].z); v[j].w = fmaf(g, bf_hi(y.y), v[j].w); } }
        float s = 0.f;
#pragma unroll
        for (int j = 0; j < 8; ++j) s += (v[j].x * v[j].x + v[j].y * v[j].y) + (v[j].z * v[j].z + v[j].w * v[j].w);
        const float r = rsqrtf(wave_sum(s) * (1.f / D) + EPS);
        const f32x4* gp = (const f32x4*)g_final + F.lane; f32x4* op = (f32x4*)(a.out + (size_t)t * D) + F.lane;
#pragma unroll
        for (int j = 0; j < 8; ++j) { const f32x4 g = gp[64 * j]; f32x4 o; o.x = v[j].x * r * g.x; o.y = v[j].y * r * g.y; o.z = v[j].z * r * g.z; o.w = v[j].w * r * g.w; op[64 * j] = o; }
    }
}

constexpr int NPHASE = 10;
__global__ void __launch_bounds__(NT, 2) mk_fwd(Args args) {
    extern __shared__ __attribute__((aligned(16))) unsigned char lds_raw[];
    Frame F; F.lds = (LAS unsigned char*)lds_raw; F.tid = threadIdx.x; F.lane = F.tid & 63; F.wave = __builtin_amdgcn_readfirstlane(F.tid >> 6);
    F.G = gridDim.x; { const int bx = blockIdx.x; F.vcu = (F.G % 8 == 0) ? (bx % 8) * (F.G / 8) + bx / 8 : bx; }
    unsigned char* ws = args.ws;
    for (int u = F.tid; u < (LDS_BYTES - LDSCTL_OFF) / 4; u += NT) ((LAS unsigned*)(F.lds + LDSCTL_OFF))[u] = 0u;
    __syncthreads();
    XcdBarrier bar; bar.bar = (unsigned*)(ws + WS_CTL) + CW_BAR; bar.x = 0; bar.st = nullptr;
    if (!MK_SPLIT) bar = xcd_barrier_post((unsigned*)(ws + WS_CTL) + CW_BAR, (volatile LAS unsigned*)(F.lds + LDSCTL_OFF) + L_MISC + 8);
    const int lo = args.ph_lo, hi = args.ph_hi;
#define IN(k) (lo <= (k) && (k) < hi)
#define SEAM(k) do { if (IN(k) && IN((k) + 1)) xcd_barrier(bar); } while (0)
    const LAS int* T = (const LAS int*)(F.lds + LDSCTL_OFF);
    if (IN(0)) { p0_prologue(F, args); } SEAM(0);
    if (IN(1)) { pg8::NatOrder So; So.init(ws + WS_XN, ws + WS_WIN, S, NPAD, F.G, (int)blockIdx.x); pg8::EpiProj E{(bf16_t*)(ws + WS_PROJ), (float*)(ws + WS_DT)};
        pg8::gemm_phase<pg8::EpiProj, pg8::NatOrder>(F.lds, So, E); } SEAM(1);
    if (IN(2)) { p2_mix(F, args); } SEAM(2);
    if (IN(3)) { ssd_scan(F, args); } SEAM(3);
    if (IN(4)) { for (int u = F.vcu; u < NCH * 2; u += F.G) ssd_c_unit(F, args, u >> 1, u & 1); } SEAM(4);
    if (IN(5)) { pg8::NatOrder So; So.init(ws + WS_MIX, ws + WS_WOUT, S, D, F.G, (int)blockIdx.x); pg8::EpiRes E{args.in[0], (float*)(ws + WS_X2)};
        pg8::gemm_phase<pg8::EpiRes, pg8::NatOrder>(F.lds, So, E); } SEAM(5);
    if (IN(6)) { p6_router(F, args); } SEAM(6);
    if (IN(7)) { moe_tables(F, args, 16);
        pg8::MoeOrder<true> So{(const char*)(ws + WS_H2), (const char*)(ws + WS_WGU), (const int*)(ws + WS_TOKOF), T + L_CNT, T + L_PFXU, T + L_POFF, 16, F.G, F.vcu};
        pg8::EpiGU E{(bf16_t*)(ws + WS_ACT), args.in[14], T + L_POFF};
        pg8::gemm_phase<pg8::EpiGU, pg8::MoeOrder<true>>(F.lds, So, E); } SEAM(7);
    if (IN(8)) { moe_tables(F, args, 8);
        pg8::MoeOrder<false> So{(const char*)(ws + WS_ACT), (const char*)(ws + WS_WDN), nullptr, T + L_CNT, T + L_PFXU, T + L_POFF, 8, F.G, F.vcu};
        pg8::EpiDown E{(bf16_t*)(ws + WS_YS), args.in[16], T + L_POFF};
        pg8::gemm_phase<pg8::EpiDown, pg8::MoeOrder<false>>(F.lds, So, E); } SEAM(8);
    if (IN(9)) { moe_tables(F, args, 8); p9_final(F, args); }
#undef IN
#undef SEAM
}

extern "C" void kernel_launch(void* const* d_in, const int* in_sizes, int n_in, void* d_out, int out_size, void* d_ws, size_t ws_size, hipStream_t stream) {
    static int grid = 0;
    if (grid == 0) {
        if (n_in != 18 || out_size != S * D || ws_size < WS_END) { fprintf(stderr, "kernel_launch: unexpected problem (n_in %d out %d ws %zu need %zu)\n", n_in, out_size, ws_size, (size_t)WS_END); grid = -1; return; }
        int dev = 0, cus = 0, per_cu = 0;
        if (hipGetDevice(&dev) != hipSuccess || hipDeviceGetAttribute(&cus, hipDeviceAttributeMultiprocessorCount, dev) != hipSuccess) { grid = -1; return; }
        if (hipFuncSetAttribute((const void*)mk_fwd, hipFuncAttributeMaxDynamicSharedMemorySize, LDS_BYTES) != hipSuccess) { fprintf(stderr, "kernel_launch: hipFuncSetAttribute failed\n"); grid = -1; return; }
        if (hipOccupancyMaxActiveBlocksPerMultiprocessor(&per_cu, (const void*)mk_fwd, NT, LDS_BYTES) != hipSuccess || per_cu < 1) { fprintf(stderr, "kernel_launch: occupancy query says %d\n", per_cu); }
        (void)hipGetLastError();
        grid = cus;
    }
    if (grid < 0) return;
    if (hipMemsetAsync((char*)d_ws + WS_CTL, 0, CTL_ZERO_BYTES, stream) != hipSuccess) return;
    Args a; memset(&a, 0, sizeof a);
    for (int i = 0; i < 18; ++i) a.in[i] = (const float*)d_in[i];
    a.out = (float*)d_out; a.ws = (unsigned char*)d_ws;
#if MK_SPLIT
    for (int p = 0; p < NPHASE; ++p) { a.ph_lo = p; a.ph_hi = p + 1; hipLaunchKernelGGL(mk_fwd, dim3(grid), dim3(NT), LDS_BYTES, stream, a); }
#else
    a.ph_lo = 0; a.ph_hi = NPHASE; hipLaunchKernelGGL(mk_fwd, dim3(grid), dim3(NT), LDS_BYTES, stream, a);
#endif
}
```

```cpp
#include <hip/hip_runtime.h>
#include <cstdio>
#include <cstdint>
#include <cstring>

#ifndef MK_SPLIT
#define MK_SPLIT 0
#endif

#ifndef PROBE_REP
#define PROBE_REP 0
#endif
#define LAS __attribute__((address_space(3)))
#define GAS __attribute__((address_space(1)))
typedef unsigned short bf16_t;
typedef short bf16x8 __attribute__((ext_vector_type(8)));
typedef float f32x4 __attribute__((ext_vector_type(4)));
typedef float f32x2 __attribute__((ext_vector_type(2)));
typedef unsigned u32x4 __attribute__((ext_vector_type(4)));
typedef unsigned u32x2 __attribute__((ext_vector_type(2)));

constexpr int S = 8192, D = 2048, H = 16, HD = 64, NE = 32, DFF = 2048;
constexpr int NPJ = 5632;
constexpr int NPAD = 5888;
constexpr int NPROJ = 5648;
constexpr int C_K = 1024, C_V = 2048, C_Z = 3072, C_XBC = 4096;
constexpr int XBC = 1536, NST = 128, NCH = 128, CL = 64;
constexpr float EPS = 1e-5f;
constexpr int ECAP = 8192;
constexpr int MAXROWS = S * 4 + NE * 256;

constexpr size_t MiB = 1u << 20;
constexpr size_t WS_CTL = 0, CTL_ZERO_BYTES = 1 * MiB;
constexpr size_t WS_WIN = 2 * MiB;
constexpr size_t WS_WOUT = WS_WIN + (size_t)NPAD * D * 2;
constexpr size_t WS_WGU = WS_WOUT + (size_t)D * D * 2;
constexpr size_t WS_WDN = WS_WGU + (size_t)NE * 2 * DFF * D * 2;
constexpr size_t WS_XN = WS_WDN + (size_t)NE * D * DFF * 2;
constexpr size_t WS_PROJ = WS_XN + (size_t)S * D * 2;
constexpr size_t WS_DT = WS_PROJ + (size_t)S * NPJ * 2;
constexpr size_t WS_ACUM = WS_DT + (size_t)S * H * 4;
constexpr size_t WS_DEC = WS_ACUM + (size_t)S * H * 4;
constexpr size_t WS_CC = WS_DEC + (size_t)NCH * H * 4;
constexpr size_t WS_Y0 = WS_CC + (size_t)S * 256 * 2;
constexpr size_t WS_SC = WS_Y0 + (size_t)S * 1024 * 4;
constexpr size_t WS_PREV = WS_SC + (size_t)NCH * H * 8192 * 2;
constexpr size_t WS_MIX = WS_PREV + (size_t)NCH * H * 8192 * 2;
constexpr size_t WS_X2 = WS_MIX + (size_t)S * D * 2;
constexpr size_t WS_H2 = WS_X2 + (size_t)S * D * 4;
constexpr size_t WS_TOKOF = WS_H2 + (size_t)S * D * 2;
constexpr size_t WS_TE = WS_TOKOF + (size_t)NE * ECAP * 4;
constexpr size_t WS_TP = WS_TE + (size_t)S * 4 * 4;
constexpr size_t WS_TG = WS_TP + (size_t)S * 4 * 4;
constexpr size_t WS_ACT = WS_TG + (size_t)S * 4 * 4;
constexpr size_t WS_YS = WS_ACT + (size_t)MAXROWS * DFF * 2;
constexpr size_t WS_END = WS_YS + (size_t)MAXROWS * D * 2;
constexpr int CW_BAR = 4096;
constexpr int CW_CNT = 8192;
constexpr int CW_ATTQ = 8448;

constexpr int RING_BYTES = 131072;
constexpr int LDSCTL_OFF = RING_BYTES;
constexpr int L_MISC = 0;
constexpr int L_CNT = 64, L_PFXU = 128, L_POFF = 192;
constexpr int LDS_BYTES = 147456;
constexpr int NWAVES = 8, NT = 512;

#define LDS_WAIT() asm volatile("s_waitcnt lgkmcnt(0)" ::: "memory")
#define VM_WAIT() asm volatile("s_waitcnt vmcnt(0)" ::: "memory")
#define RLX_AGENT __ATOMIC_RELAXED, __HIP_MEMORY_SCOPE_AGENT
typedef __bf16 bf16v2 __attribute__((ext_vector_type(2)));
__device__ __forceinline__ unsigned cvt_pk_bf16(float lo, float hi) { f32x2 v = {lo, hi}; bf16v2 r = __builtin_convertvector(v, bf16v2); return __builtin_bit_cast(unsigned, r); }
__device__ __forceinline__ float bf_lo(unsigned u) { return __builtin_bit_cast(float, u << 16); }
__device__ __forceinline__ float bf_hi(unsigned u) { return __builtin_bit_cast(float, u & 0xffff0000u); }
__device__ __forceinline__ float wave_sum(float v) {
#pragma unroll
    for (int o = 1; o < 64; o <<= 1) v += __shfl_xor(v, o);
    return v;
}
__device__ __forceinline__ float softplus_acc(float x) { return fmaxf(x, 0.f) + log1pf(expf(-fabsf(x))); }
__device__ __forceinline__ float silu_acc(float x) { return x / (1.f + expf(-x)); }

#define XB_TMO      128
#define XB_XCNT(j)  (256  + 64 * (j))
#define XB_XSUB(j)  (1280 + 64 * (j))
#define XB_XGEN(j)  (2304 + 64 * (j))
#define XB_TOP      3328
#define XB_TOPGEN   3392
#define XCD_BAR_WORDS 3456
#define XB_SPIN_CAP (1u << 18)
__device__ __forceinline__ unsigned xb_ld(unsigned* p)              { return __hip_atomic_load(p, __ATOMIC_RELAXED, __HIP_MEMORY_SCOPE_AGENT); }
__device__ __forceinline__ unsigned xb_add(unsigned* p, unsigned v) { return __hip_atomic_fetch_add(p, v, __ATOMIC_RELAXED, __HIP_MEMORY_SCOPE_AGENT); }
__device__ __forceinline__ unsigned xb_xcc_id() { return (unsigned)__builtin_amdgcn_s_getreg((3 << 11) | 20) & 0xFu; }
#define XB_SPIN(cond, bar) do { unsigned _sp = 0; while (cond) { __builtin_amdgcn_s_sleep(1); \
    if ((++_sp & 255u) == 0u) { if (xb_ld(&(bar)[XB_TMO])) break; if (_sp > XB_SPIN_CAP) { atomicAdd(&(bar)[XB_TMO], 1u); break; } } } } while (0)
struct XcdBarrier { unsigned* bar; unsigned x; volatile LAS unsigned* st; };
__device__ __forceinline__ XcdBarrier xcd_barrier_post(unsigned* bar, volatile LAS unsigned* st) {
    XcdBarrier b; b.bar = bar; b.x = xb_xcc_id(); b.st = st;
    if (threadIdx.x == 0) (void)xb_add(&bar[XB_XCNT(b.x)], 1u);
    return b;
}
__device__ __forceinline__ void xcd_barrier_complete(unsigned* bar, unsigned x, unsigned& nloc, unsigned& nx) {
    const unsigned G = gridDim.x * gridDim.y * gridDim.z;
    unsigned sum, cnt, mine, sp = 0u;
    for (;;) {
        sum = 0u; cnt = 0u; mine = 0u;
#pragma unroll
        for (unsigned j = 0; j < 16; ++j) { const unsigned c = xb_ld(&bar[XB_XCNT(j)]); sum += c; cnt += (c > 0u) ? 1u : 0u; mine = (j == x) ? c : mine; }
        if (sum == G) break;
        __builtin_amdgcn_s_sleep(1);
        if ((++sp & 255u) == 0u) { if (xb_ld(&bar[XB_TMO])) break; if (sp > XB_SPIN_CAP) { atomicAdd(&bar[XB_TMO], 1u); break; } }
    }
    nloc = mine > 0u ? mine : 1u; nx = cnt > 0u ? cnt : 1u;
}
__device__ __forceinline__ void xcd_barrier(const XcdBarrier& b) {
    asm volatile("s_waitcnt vmcnt(0)" ::: "memory");
    __syncthreads();
    if (threadIdx.x == 0) {
        unsigned* bar = b.bar;
        __builtin_amdgcn_s_waitcnt(0);
        unsigned nloc = b.st[0], nx = b.st[1];
        if (nloc == 0u) { xcd_barrier_complete(bar, b.x, nloc, nx); b.st[0] = nloc; b.st[1] = nx; }
        const unsigned old = xb_add(&bar[XB_XSUB(b.x)], 1u);
        const unsigned gen = old / nloc;
        if (old + 1u == (gen + 1u) * nloc) {
            __builtin_amdgcn_fence(__ATOMIC_RELEASE, "agent");
            asm volatile("s_waitcnt vmcnt(0)" ::: "memory");
            const unsigned og = xb_add(&bar[XB_TOP], 1u);
            const unsigned tg = og / nx;
            if (og + 1u == (tg + 1u) * nx) xb_add(&bar[XB_TOPGEN], 1u);
            else XB_SPIN(xb_ld(&bar[XB_TOPGEN]) == tg, bar);
            __builtin_amdgcn_fence(__ATOMIC_ACQUIRE, "agent");
            xb_add(&bar[XB_XGEN(b.x)], 1u);
            asm volatile("s_waitcnt vmcnt(0)" ::: "memory");
        } else {
            XB_SPIN(xb_ld(&bar[XB_XGEN(b.x)]) == gen, bar);
            __builtin_amdgcn_fence(__ATOMIC_ACQUIRE, "agent");
            asm volatile("s_waitcnt vmcnt(0)" ::: "memory");
        }
    }
    __syncthreads();
}

namespace pg8 {
constexpr int BM = 256, BK = 64, HALF = 128, HTB = HALF * BK * 2, NXCD = 8, WGM = 8, K = 2048, NTK = K / BK;
constexpr unsigned HSTEP = (unsigned)HALF * K * 2;
constexpr size_t TSTEP = 2 * (size_t)HSTEP;
__host__ __device__ __forceinline__ int lds_byte(int r, int c) { const int st = (r >> 4) * 2 + (c >> 5), rr = r & 15, cc = c & 31, ob = rr * 64 + cc * 2; return st * 1024 + (ob ^ (((ob >> 9) & 1) << 5)); }
__host__ __device__ __forceinline__ void stage_rc(int b, int& R, int& C) { const int st = b / 1024, sb = b % 1024, swz = sb ^ (((sb >> 9) & 1) << 5); R = (st >> 1) * 16 + swz / 64; C = (st & 1) * 32 + (swz % 64) / 2; }
__host__ __device__ __forceinline__ int perm32(int rho) { const int n = rho >> 4, i = rho & 15; return 8 * (i >> 2) + 4 * n + (i & 3); }
struct Unit { int pm, pn, e; };

struct NatOrder {
    const char* A; const char* Bt; int nM, nN, nwg, G, c;
    __device__ void init(const void* A_, const void* Bt_, int M, int N, int G_, int c_) { A = (const char*)A_; Bt = (const char*)Bt_; nM = M / BM; nN = N / BM; nwg = nM * nN; G = G_; c = c_; }
    __device__ __forceinline__ bool next(int i, Unit& u) const {
        const long L = (long)i * G + c; if (L >= nwg) return false;
        int wgid = (int)L; { const int q = nwg / NXCD, r = nwg % NXCD, xcd = wgid % NXCD, off = wgid / NXCD; wgid = (xcd < r ? xcd * (q + 1) : r * (q + 1) + (xcd - r) * q) + off; }
        const int nig = WGM * nN, gid = wgid / nig, fm = gid * WGM, gsz = (nM - fm) < WGM ? (nM - fm) : WGM;
        u.pm = fm + ((wgid % nig) % gsz); u.pn = (wgid % nig) / gsz; u.e = 0; return true;
    }
    __device__ __forceinline__ const char* a_base(const Unit& u) const { return A + (size_t)u.pm * TSTEP; }
    __device__ __forceinline__ const char* b_base(const Unit& u) const { return Bt + (size_t)u.pn * TSTEP; }
    __device__ __forceinline__ void a_offs(const Unit&, const unsigned (&nat)[2], unsigned (&v)[4]) const { v[0] = nat[0]; v[1] = nat[1]; v[2] = nat[0] + HSTEP; v[3] = nat[1] + HSTEP; }
};
template <bool GATHER> struct MoeOrder {
    const char* A; const char* Bt; const int* tokof; const LAS int* cnt; const LAS int* pfxU; const LAS int* poff; int ntn, G, c;
    __device__ __forceinline__ bool next(int i, Unit& u) const {
        const int L = i * G + c; if (L >= pfxU[NE]) return false;
        int e = 0;
#pragma unroll 1
        for (; e < NE - 1; ++e) if (L < pfxU[e + 1]) break;
        const int r = L - pfxU[e], mt = (cnt[e] + 255) >> 8;
        u.e = e; u.pn = r / mt; u.pm = r - u.pn * mt; return true;
    }
    __device__ __forceinline__ const char* a_base(const Unit& u) const { return GATHER ? A : A + ((size_t)poff[u.e] + (size_t)u.pm * BM) * (K * 2); }
    __device__ __forceinline__ const char* b_base(const Unit& u) const { return Bt + ((size_t)u.e * ntn + u.pn) * TSTEP; }
    __device__ __forceinline__ void a_offs(const Unit& u, const unsigned (&nat)[2], unsigned (&v)[4]) const {
        if (!GATHER) { v[0] = nat[0]; v[1] = nat[1]; v[2] = nat[0] + HSTEP; v[3] = nat[1] + HSTEP; return; }
        const int n = cnt[u.e];
#pragma unroll
        for (int h = 0; h < 2; ++h)
#pragma unroll
            for (int i = 0; i < 2; ++i) { const unsigned R = nat[i] / (K * 2), Cb = nat[i] % (K * 2); int pos = u.pm * BM + h * HALF + (int)R; pos = pos < n ? pos : n - 1;
                const int tok = tokof[u.e * ECAP + pos]; v[h * 2 + i] = (unsigned)tok * (K * 2) + Cb; }
    }
};

struct EpiProj {
    static constexpr bool PERM = true;
    bf16_t* P; float* DT;
    __device__ __forceinline__ void operator()(const f32x4 (&acc)[2][2][4][2], const Unit& u, int wr, int wc, int fr, int fq) const {
        const int row0 = u.pm * BM + wr * 64 + fr, col0 = u.pn * BM + wc * 32 + 8 * fq;
        if (u.pn < 22) {
#pragma unroll
            for (int ai = 0; ai < 2; ++ai)
#pragma unroll
                for (int m = 0; m < 4; ++m) { bf16_t* rowp = P + (size_t)(row0 + ai * HALF + m * 16) * NPJ + col0;
#pragma unroll
                    for (int bj = 0; bj < 2; ++bj) { const f32x4 v0 = acc[ai][bj][m][0], v1 = acc[ai][bj][m][1];
                        u32x4 w; w.x = cvt_pk_bf16(v0[0], v0[1]); w.y = cvt_pk_bf16(v0[2], v0[3]); w.z = cvt_pk_bf16(v1[0], v1[1]); w.w = cvt_pk_bf16(v1[2], v1[3]);
                        *(u32x4*)(rowp + bj * HALF) = w; } }
        } else if (wc == 0 && fq < 2) {
#pragma unroll
            for (int ai = 0; ai < 2; ++ai)
#pragma unroll
                for (int m = 0; m < 4; ++m) { float* rowp = DT + (size_t)(row0 + ai * HALF + m * 16) * H + 8 * fq;
                    *(f32x4*)(rowp) = acc[ai][0][m][0]; *(f32x4*)(rowp + 4) = acc[ai][0][m][1]; }
        }
    }
};
struct EpiRes {
    static constexpr bool PERM = false;
    const float* X; float* O;
    __device__ __forceinline__ void operator()(const f32x4 (&acc)[2][2][4][2], const Unit& u, int wr, int wc, int fr, int fq) const {
        const int row0 = u.pm * BM + wr * 64 + fr, col0 = u.pn * BM + wc * 32 + 4 * fq;
#pragma unroll
        for (int ai = 0; ai < 2; ++ai)
#pragma unroll
            for (int m = 0; m < 4; ++m) { const size_t ro = (size_t)(row0 + ai * HALF + m * 16) * D + col0;
#pragma unroll
                for (int bj = 0; bj < 2; ++bj)
#pragma unroll
                    for (int n = 0; n < 2; ++n) { const f32x4 xv = *(const f32x4*)(X + ro + bj * HALF + n * 16); *(f32x4*)(O + ro + bj * HALF + n * 16) = acc[ai][bj][m][n] + xv; } }
    }
};
struct EpiGU {
    static constexpr bool PERM = true;
    bf16_t* ACT; const float* bias; const LAS int* poff;
    __device__ __forceinline__ float act1(float g, float up) const { g = fminf(g, 7.f); up = fminf(fmaxf(up, -7.f), 7.f); return g * (1.f / (1.f + __expf(-1.702f * g))) * (up + 1.f); }
    __device__ __forceinline__ void operator()(const f32x4 (&acc)[2][2][4][2], const Unit& u, int wr, int wc, int fr, int fq) const {
        const int row0 = poff[u.e] + u.pm * BM + wr * 64 + fr, col0 = u.pn * BM + wc * 32 + 8 * fq;
        const float* bp = bias + (size_t)u.e * (2 * DFF) + col0;
        f32x4 bv[2][2];
#pragma unroll
        for (int bj = 0; bj < 2; ++bj)
#pragma unroll
            for (int n = 0; n < 2; ++n) bv[bj][n] = *(const f32x4*)(bp + bj * HALF + 4 * n);
#pragma unroll
        for (int ai = 0; ai < 2; ++ai)
#pragma unroll
            for (int m = 0; m < 4; ++m) { bf16_t* rowp = ACT + (size_t)(row0 + ai * HALF + m * 16) * DFF + (col0 >> 1);
#pragma unroll
                for (int bj = 0; bj < 2; ++bj) { const f32x4 v0 = acc[ai][bj][m][0] + bv[bj][0], v1 = acc[ai][bj][m][1] + bv[bj][1];
                    u32x2 w; w.x = cvt_pk_bf16(act1(v0[0], v0[1]), act1(v0[2], v0[3])); w.y = cvt_pk_bf16(act1(v1[0], v1[1]), act1(v1[2], v1[3]));
                    *(u32x2*)(rowp + bj * (HALF / 2)) = w; } }
    }
};
struct EpiDown {
    static constexpr bool PERM = true;
    bf16_t* YS; const float* bias; const LAS int* poff;
    __device__ __forceinline__ void operator()(const f32x4 (&acc)[2][2][4][2], const Unit& u, int wr, int wc, int fr, int fq) const {
        const int row0 = poff[u.e] + u.pm * BM + wr * 64 + fr, col0 = u.pn * BM + wc * 32 + 8 * fq;
        const float* bp = bias + (size_t)u.e * D + col0;
        f32x4 bv[2][2];
#pragma unroll
        for (int bj = 0; bj < 2; ++bj)
#pragma unroll
            for (int n = 0; n < 2; ++n) bv[bj][n] = *(const f32x4*)(bp + bj * HALF + 4 * n);
#pragma unroll
        for (int ai = 0; ai < 2; ++ai)
#pragma unroll
            for (int m = 0; m < 4; ++m) { bf16_t* rowp = YS + (size_t)(row0 + ai * HALF + m * 16) * D + col0;
#pragma unroll
                for (int bj = 0; bj < 2; ++bj) { const f32x4 v0 = acc[ai][bj][m][0] + bv[bj][0], v1 = acc[ai][bj][m][1] + bv[bj][1];
                    u32x4 w; w.x = cvt_pk_bf16(v0[0], v0[1]); w.y = cvt_pk_bf16(v0[2], v0[3]); w.z = cvt_pk_bf16(v1[0], v1[1]); w.w = cvt_pk_bf16(v1[2], v1[3]);
                    *(u32x4*)(rowp + bj * HALF) = w; } }
    }
};

template <class Epi, class Sched>
__device__ __forceinline__ void gemm_phase(LAS unsigned char* lds, const Sched& S, const Epi& E) {
    const int tid = threadIdx.x, wid = __builtin_amdgcn_readfirstlane(tid >> 6), lane = tid & 63, wr = wid >> 2, wc = wid & 3, fr = lane & 15, fq = lane >> 4;
    unsigned natA[2], voffB[2];
#pragma unroll
    for (int i = 0; i < 2; ++i) { int R, C; stage_rc(tid * 16 + i * 8192, R, C); const int Rb = Epi::PERM ? ((R & ~31) + perm32(R & 31)) : R;
        natA[i] = (unsigned)(R * K + C) * 2u; voffB[i] = (unsigned)(Rb * K + C) * 2u; }
    const size_t kstep = (size_t)(BK * 2);
    const unsigned ldsw = (unsigned)wid * 1024u;
    const int aoff = lds_byte(wr * 64 + fr, fq * 8), boff = lds_byte(wc * 32 + fr, fq * 8);
#define PG8_SA(b, h) (((b) * 2 + (h)) * HTB)
#define PG8_SB(b, h) ((4 + (b) * 2 + (h)) * HTB)
#define PG8_STAGE_A(bufoff, gbase, h) do { _Pragma("unroll") for (int _i = 0; _i < 2; ++_i) \
        __builtin_amdgcn_global_load_lds((const unsigned*)((const char*)(gbase) + va[(h) * 2 + _i]), (LAS unsigned*)(lds + (bufoff) + ldsw + _i * 8192), 16, 0, 0); } while (0)
#define PG8_STAGE_B(bufoff, gbase) do { _Pragma("unroll") for (int _i = 0; _i < 2; ++_i) \
        __builtin_amdgcn_global_load_lds((const unsigned*)((const char*)(gbase) + voffB[_i]), (LAS unsigned*)(lds + (bufoff) + ldsw + _i * 8192), 16, 0, 0); } while (0)
#define PG8_LDA(dst, b, h) do { _Pragma("unroll") for (int m = 0; m < 4; ++m) _Pragma("unroll") for (int k = 0; k < 2; ++k) dst[m][k] = *(const LAS bf16x8*)(lds + PG8_SA(b, h) + aoff + m * 2048 + k * 1024); } while (0)
#define PG8_LDB(dst, b, h) do { _Pragma("unroll") for (int n = 0; n < 2; ++n) _Pragma("unroll") for (int k = 0; k < 2; ++k) dst[n][k] = *(const LAS bf16x8*)(lds + PG8_SB(b, h) + boff + n * 2048 + k * 1024); } while (0)
#define PG8_MMA(ai, bj, At, Bt) do { __builtin_amdgcn_s_setprio(1); _Pragma("unroll") for (int m = 0; m < 4; ++m) _Pragma("unroll") for (int n = 0; n < 2; ++n) _Pragma("unroll") for (int k = 0; k < 2; ++k) \
        acc[ai][bj][m][n] = __builtin_amdgcn_mfma_f32_16x16x32_bf16(Bt[n][k], At[m][k], acc[ai][bj][m][n], 0, 0, 0); __builtin_amdgcn_s_setprio(0); } while (0)
#define PG8_WAIT_V(n) asm volatile("s_waitcnt vmcnt(" #n ")" ::: "memory")
#define PG8_WAIT_L(n) asm volatile("s_waitcnt lgkmcnt(" #n ")" ::: "memory")
#define PG8_BAR __builtin_amdgcn_s_barrier()
#define PG8_SCHED __builtin_amdgcn_sched_barrier(0)
    Unit cur, nxt; int ui = 0;
    if (!S.next(0, cur)) return;
    f32x4 acc[2][2][4][2];
#pragma unroll
    for (int a = 0; a < 2; ++a)
#pragma unroll
        for (int b = 0; b < 2; ++b)
#pragma unroll
            for (int m = 0; m < 4; ++m)
#pragma unroll
                for (int n = 0; n < 2; ++n) acc[a][b][m][n] = (f32x4){0.f, 0.f, 0.f, 0.f};
    bf16x8 At[4][2], B0[2][2], B1[2][2];
    unsigned va[4]; S.a_offs(cur, natA, va);
    const char* cA = S.a_base(cur); const char* cB = S.b_base(cur);
    PG8_STAGE_B(PG8_SB(0, 0), cB); PG8_STAGE_B(PG8_SB(0, 1), cB + HSTEP); PG8_STAGE_A(PG8_SA(0, 0), cA, 0); PG8_STAGE_A(PG8_SA(0, 1), cA, 1);
    if (wr == 1) PG8_BAR;
    PG8_WAIT_V(2); PG8_BAR;
    PG8_STAGE_B(PG8_SB(1, 0), cB + kstep); PG8_STAGE_A(PG8_SA(1, 0), cA + kstep, 0); PG8_STAGE_B(PG8_SB(1, 1), cB + HSTEP + kstep);
    PG8_WAIT_V(6); PG8_BAR;
    for (;;) {
        const bool has_next = S.next(ui + 1, nxt);
        const char* nA = has_next ? S.a_base(nxt) : cA; const char* nB = has_next ? S.b_base(nxt) : cB;
        for (int t = 0; t < NTK; t += 2) {
            const bool last = (t == NTK - 2);
            const char* a1 = cA + (size_t)(t + 1) * kstep;
            const char* a2 = last ? nA : cA + (size_t)(t + 2) * kstep; const char* b2 = last ? nB : cB + (size_t)(t + 2) * kstep;
            const char* a3 = a2 + kstep; const char* b3 = b2 + kstep;
            unsigned vn[4] = {va[0], va[1], va[2], va[3]};
            if (last && has_next) S.a_offs(nxt, natA, vn);
            PG8_LDB(B0, 0, 0); PG8_LDB(B1, 0, 1); PG8_SCHED; PG8_LDA(At, 0, 0); PG8_STAGE_A(PG8_SA(1, 1), a1, 1);
            PG8_WAIT_V(8); PG8_WAIT_L(0); PG8_BAR; PG8_MMA(0, 0, At, B0); PG8_MMA(0, 1, At, B1); PG8_BAR; PG8_SCHED;
            if (last) { va[0] = vn[0]; va[1] = vn[1]; va[2] = vn[2]; va[3] = vn[3]; }
            PG8_LDA(At, 0, 1); PG8_STAGE_B(PG8_SB(0, 0), b2); PG8_STAGE_B(PG8_SB(0, 1), b2 + HSTEP); PG8_STAGE_A(PG8_SA(0, 0), a2, 0);
            PG8_WAIT_V(8); PG8_WAIT_L(0); PG8_BAR; PG8_MMA(1, 0, At, B0); PG8_MMA(1, 1, At, B1); PG8_BAR; PG8_SCHED;
            PG8_LDB(B0, 1, 0); PG8_LDB(B1, 1, 1); PG8_SCHED; PG8_LDA(At, 1, 0); PG8_STAGE_A(PG8_SA(0, 1), a2, 1);
            PG8_WAIT_V(8); PG8_WAIT_L(0); PG8_BAR; PG8_MMA(0, 0, At, B0); PG8_MMA(0, 1, At, B1); PG8_BAR; PG8_SCHED;
            PG8_LDA(At, 1, 1); PG8_STAGE_B(PG8_SB(1, 0), b3); PG8_STAGE_B(PG8_SB(1, 1), b3 + HSTEP); PG8_STAGE_A(PG8_SA(1, 0), a3, 0);
            PG8_WAIT_V(8); PG8_WAIT_L(0); PG8_BAR; PG8_MMA(1, 0, At, B0); PG8_MMA(1, 1, At, B1); PG8_BAR; PG8_SCHED;
        }
        if (wr == 0) PG8_BAR;
        E(acc, cur, wr, wc, fr, fq);
        if (!has_next) break;
#pragma unroll
        for (int a = 0; a < 2; ++a)
#pragma unroll
            for (int b = 0; b < 2; ++b)
#pragma unroll
                for (int m = 0; m < 4; ++m)
#pragma unroll
                    for (int n = 0; n < 2; ++n) acc[a][b][m][n] = (f32x4){0.f, 0.f, 0.f, 0.f};
        cur = nxt; cA = nA; cB = nB; ++ui;
        if (wr == 1) PG8_BAR;
    }
    PG8_WAIT_V(0);
    PG8_BAR;
#undef PG8_SA
#undef PG8_SB
#undef PG8_STAGE_A
#undef PG8_STAGE_B
#undef PG8_LDA
#undef PG8_LDB
#undef PG8_MMA
#undef PG8_WAIT_V
#undef PG8_WAIT_L
#undef PG8_BAR
#undef PG8_SCHED
}
}

struct Args { const float* in[18]; float* out; unsigned char* ws; int ph_lo, ph_hi; };
struct Frame { LAS unsigned char* lds; int tid, lane, wave, vcu, G; };
__device__ __forceinline__ int fresh_lane() { int t = threadIdx.x; asm volatile("" : "+v"(t)); return t & 63; }

__device__ __forceinline__ void transpose_item(const float* W, int ldw, int nvalid, bf16_t* WT, LAS float* scr, int kb, int nb, int lane) {
    const int k0 = 64 * kb, n0 = 32 * nb, nn = n0 + (lane & 31); const bool ok = nn < nvalid;
    const float* src = W + (size_t)(k0 + (lane >> 5)) * ldw + (ok ? nn : 0);
    float v[32];
#pragma unroll
    for (int i = 0; i < 32; ++i) v[i] = src[(size_t)(2 * i) * ldw];
#pragma unroll
    for (int i = 0; i < 32; ++i) scr[(2 * i + (lane >> 5)) * 33 + (lane & 31)] = ok ? v[i] : 0.f;
    LDS_WAIT(); asm volatile("" ::: "memory");
    const int c = lane & 7;
#pragma unroll
    for (int j = 0; j < 4; ++j) { const int n = (lane >> 3) + 8 * j; const LAS float* s = scr + (8 * c) * 33 + n;
        u32x4 o; o.x = cvt_pk_bf16(s[0 * 33], s[1 * 33]); o.y = cvt_pk_bf16(s[2 * 33], s[3 * 33]); o.z = cvt_pk_bf16(s[4 * 33], s[5 * 33]); o.w = cvt_pk_bf16(s[6 * 33], s[7 * 33]);
        *(u32x4*)(WT + (size_t)(n0 + n) * 2048 + k0 + 8 * c) = o; }
    LDS_WAIT(); asm volatile("" ::: "memory");
}
__device__ __forceinline__ float rms_load(const float* xrow, int lane, f32x4 (&v)[8]) {
    const f32x4* xr = (const f32x4*)xrow + lane; float s = 0.f;
#pragma unroll
    for (int j = 0; j < 8; ++j) { v[j] = xr[64 * j]; s += (v[j].x * v[j].x + v[j].y * v[j].y) + (v[j].z * v[j].z + v[j].w * v[j].w); }
    return rsqrtf(wave_sum(s) * (1.f / D) + EPS);
}

__device__ __forceinline__ void p0_prologue(const Frame& F, const Args& a) {
    LAS float* scr = (LAS float*)(F.lds + F.wave * 16384);
    const int gw = F.vcu * NWAVES + F.wave, NGW = F.G * NWAVES;
    const float* x = a.in[0]; const float* g_mix = a.in[1]; const float* w_in = a.in[2]; const float* w_out = a.in[9]; const float* w_gu = a.in[13]; const float* w_dn = a.in[15];
    bf16_t* WinT = (bf16_t*)(a.ws + WS_WIN); bf16_t* WoutT = (bf16_t*)(a.ws + WS_WOUT); bf16_t* WguT = (bf16_t*)(a.ws + WS_WGU); bf16_t* WdnT = (bf16_t*)(a.ws + WS_WDN); bf16_t* XN = (bf16_t*)(a.ws + WS_XN);
    for (int m = gw; m < S; m += NGW) { f32x4 v[8]; const float r = rms_load(x + (size_t)m * D, F.lane, v);
        const f32x4* gp = (const f32x4*)g_mix + F.lane; u32x2* o8 = (u32x2*)(XN + (size_t)m * D) + F.lane;
#pragma unroll
        for (int j = 0; j < 8; ++j) { const f32x4 g = gp[64 * j]; u32x2 w; w.x = cvt_pk_bf16(v[j].x * r * g.x, v[j].y * r * g.y); w.y = cvt_pk_bf16(v[j].z * r * g.z, v[j].w * r * g.w); o8[64 * j] = w; } }
    constexpr int I_IN = 32 * (NPAD / 32), I_OUT = 32 * (D / 32), I_GU = 32 * (2 * DFF / 32), I_DN = 32 * (D / 32);
    constexpr int NITEMS = I_IN + I_OUT + NE * I_GU + NE * I_DN;
    for (int it = gw; it < NITEMS; it += NGW) {
        int r = it;
        if (r < I_IN) { transpose_item(w_in, NPROJ, NPROJ, WinT, scr, r / (NPAD / 32), r % (NPAD / 32), F.lane); continue; } r -= I_IN;
        if (r < I_OUT) { transpose_item(w_out, D, D, WoutT, scr, r / (D / 32), r % (D / 32), F.lane); continue; } r -= I_OUT;
        if (r < NE * I_GU) { const int e = r / I_GU, q = r % I_GU; transpose_item(w_gu + (size_t)e * D * 2 * DFF, 2 * DFF, 2 * DFF, WguT + (size_t)e * 2 * DFF * D, scr, q / (2 * DFF / 32), q % (2 * DFF / 32), F.lane); continue; } r -= NE * I_GU;
        { const int e = r / I_DN, q = r % I_DN; transpose_item(w_dn + (size_t)e * DFF * D, D, D, WdnT + (size_t)e * D * DFF, scr, q / (D / 32), q % (D / 32), F.lane); }
    }
}

constexpr int XS_STRIDE = 1024 + 16, BS_STRIDE = 256 + 16;
constexpr int L_XS = 0, L_BS = 64 * XS_STRIDE, L_CS = L_BS + 64 * BS_STRIDE, L_WV = L_CS + 64 * BS_STRIDE;
static_assert(L_WV + 8 * 768 <= RING_BYTES, "ssd lds");
__device__ __forceinline__ void tr_read2(unsigned a0, unsigned a1, u32x2& r0, u32x2& r1) {
    asm volatile("ds_read_b64_tr_b16 %0, %2\n\tds_read_b64_tr_b16 %1, %3\n\ts_waitcnt lgkmcnt(0)" : "=&v"(r0), "=&v"(r1) : "v"(a0), "v"(a1) : "memory");
}
__device__ __forceinline__ void tr_read8(unsigned a0, unsigned a1, u32x2 (&r)[8]) {
    asm volatile("ds_read_b64_tr_b16 %0, %8\n\tds_read_b64_tr_b16 %1, %9\n\tds_read_b64_tr_b16 %2, %8 offset:32\n\tds_read_b64_tr_b16 %3, %9 offset:32\n\t"
                 "ds_read_b64_tr_b16 %4, %8 offset:64\n\tds_read_b64_tr_b16 %5, %9 offset:64\n\tds_read_b64_tr_b16 %6, %8 offset:96\n\tds_read_b64_tr_b16 %7, %9 offset:96\n\ts_waitcnt lgkmcnt(0)"
                 : "=&v"(r[0]), "=&v"(r[1]), "=&v"(r[2]), "=&v"(r[3]), "=&v"(r[4]), "=&v"(r[5]), "=&v"(r[6]), "=&v"(r[7]) : "v"(a0), "v"(a1) : "memory");
}
__device__ __forceinline__ bf16x8 mk_frag(u32x2 lo, u32x2 hi) { u32x4 v; v.x = lo.x; v.y = lo.y; v.z = hi.x; v.w = hi.y; return __builtin_bit_cast(bf16x8, v); }
__device__ __forceinline__ float silu_fast(float x) { return x * __builtin_amdgcn_rcpf(1.f + __expf(-x)); }

__device__ __forceinline__ void ssd_a_unit(const Frame& F, const Args& a, int c, int g) {
    const bf16_t* PROJ = (const bf16_t*)(a.ws + WS_PROJ); const float* DT = (const float*)(a.ws + WS_DT);
    float* ACUM = (float*)(a.ws + WS_ACUM); float* DEC = (float*)(a.ws + WS_DEC); bf16_t* CC = (bf16_t*)(a.ws + WS_CC); float* Y0 = (float*)(a.ws + WS_Y0); bf16_t* SC = (bf16_t*)(a.ws + WS_SC);
    const float* cw = a.in[3]; const float* cb = a.in[4];
    int tid = F.tid; asm volatile("" : "+v"(tid));
    const int t0 = c * CL, lane = tid & 63, w = F.wave, h = g * 8 + w;
    LAS unsigned char* lds = F.lds;
    if (tid < 384) {
        const int cg = tid % 96, tr = tid / 96;
        int ch, dstride; LAS unsigned char* dst;
        if (cg < 64) { ch = g * 512 + cg * 8; dst = lds + L_XS + cg * 16; dstride = XS_STRIDE; }
        else if (cg < 80) { ch = 1024 + g * 128 + (cg - 64) * 8; dst = lds + L_BS + (cg - 64) * 16; dstride = BS_STRIDE; }
        else { ch = 1280 + g * 128 + (cg - 80) * 8; dst = lds + L_CS + (cg - 80) * 16; dstride = BS_STRIDE; }
        float wt[4][8], bs[8];
#pragma unroll
        for (int k = 0; k < 4; ++k) { const f32x4 w0 = *(const f32x4*)(cw + k * XBC + ch), w1 = *(const f32x4*)(cw + k * XBC + ch + 4);
            wt[k][0] = w0.x; wt[k][1] = w0.y; wt[k][2] = w0.z; wt[k][3] = w0.w; wt[k][4] = w1.x; wt[k][5] = w1.y; wt[k][6] = w1.z; wt[k][7] = w1.w; }
        { const f32x4 b0 = *(const f32x4*)(cb + ch), b1 = *(const f32x4*)(cb + ch + 4); bs[0] = b0.x; bs[1] = b0.y; bs[2] = b0.z; bs[3] = b0.w; bs[4] = b1.x; bs[5] = b1.y; bs[6] = b1.z; bs[7] = b1.w; }
        const int tb = t0 + tr * 16;
        u32x4 rows[19];
#pragma unroll
        for (int i = 0; i < 19; ++i) { const int tt = tb - 3 + i; rows[i] = (u32x4){0u, 0u, 0u, 0u}; if (tt >= 0) rows[i] = *(const u32x4*)(PROJ + (size_t)tt * NPJ + C_XBC + ch); }
#pragma unroll
        for (int i = 0; i < 16; ++i) {
            float acc[8];
#pragma unroll
            for (int j = 0; j < 8; ++j) acc[j] = bs[j];
#pragma unroll
            for (int k = 0; k < 4; ++k) { const u32x4 xv = rows[i + k];
                acc[0] = fmaf(wt[k][0], bf_lo(xv.x), acc[0]); acc[1] = fmaf(wt[k][1], bf_hi(xv.x), acc[1]); acc[2] = fmaf(wt[k][2], bf_lo(xv.y), acc[2]); acc[3] = fmaf(wt[k][3], bf_hi(xv.y), acc[3]);
                acc[4] = fmaf(wt[k][4], bf_lo(xv.z), acc[4]); acc[5] = fmaf(wt[k][5], bf_hi(xv.z), acc[5]); acc[6] = fmaf(wt[k][6], bf_lo(xv.w), acc[6]); acc[7] = fmaf(wt[k][7], bf_hi(xv.w), acc[7]); }
            u32x4 o; o.x = cvt_pk_bf16(silu_fast(acc[0]), silu_fast(acc[1])); o.y = cvt_pk_bf16(silu_fast(acc[2]), silu_fast(acc[3])); o.z = cvt_pk_bf16(silu_fast(acc[4]), silu_fast(acc[5])); o.w = cvt_pk_bf16(silu_fast(acc[6]), silu_fast(acc[7]));
            *(LAS u32x4*)(dst + (tr * 16 + i) * dstride) = o;
            if (cg >= 80) *(u32x4*)(CC + (size_t)(tb + i) * 256 + g * 128 + (cg - 80) * 8) = o;
        }
    }
    __syncthreads();
    const int fr = lane & 15, fq = lane >> 4;
    LAS float* wv = (LAS float*)(lds + L_WV + w * 768);
    const float Ah = -expf(a.in[6][h]), Dh = a.in[7][h];
    {
        const float dtv = softplus_acc(DT[(size_t)(t0 + lane) * H + h] + a.in[5][h]);
        float ac = dtv * Ah;
#pragma unroll
        for (int o = 1; o < 64; o <<= 1) { const float n = __shfl_up(ac, o); if (lane >= o) ac += n; }
        const float atot = __shfl(ac, 63);
        wv[lane] = ac; wv[64 + lane] = dtv; wv[128 + lane] = dtv * __expf(atot - ac);
        ACUM[(size_t)(t0 + lane) * H + h] = ac; if (lane == 0) DEC[c * H + h] = __expf(atot);
    }
    LDS_WAIT();
    const unsigned lbase = (unsigned)(uintptr_t)lds;
    f32x4 cbt[4][4];
#pragma unroll
    for (int i = 0; i < 4; ++i)
#pragma unroll
        for (int j = 0; j < 4; ++j) cbt[i][j] = (f32x4){0.f, 0.f, 0.f, 0.f};
#pragma unroll
    for (int kk = 0; kk < 4; ++kk) { bf16x8 af[4], bfr[4];
#pragma unroll
        for (int i = 0; i < 4; ++i) { af[i] = *(const LAS bf16x8*)(lds + L_BS + (16 * i + fr) * BS_STRIDE + (32 * kk + 8 * fq) * 2); bfr[i] = *(const LAS bf16x8*)(lds + L_CS + (16 * i + fr) * BS_STRIDE + (32 * kk + 8 * fq) * 2); }
#pragma unroll
        for (int i = 0; i < 4; ++i)
#pragma unroll
            for (int j = 0; j < 4; ++j) cbt[i][j] = __builtin_amdgcn_mfma_f32_16x16x32_bf16(af[i], bfr[j], cbt[i][j], 0, 0, 0); }
    bf16x8 mt[4][2];
    {
        float acl[4];
#pragma unroll
        for (int j = 0; j < 4; ++j) acl[j] = wv[16 * j + fr];
#pragma unroll
        for (int u = 0; u < 2; ++u) {
            const f32x4 as0 = *(const LAS f32x4*)(wv + 32 * u + 4 * fq), as1 = *(const LAS f32x4*)(wv + 32 * u + 16 + 4 * fq);
            const f32x4 ds0 = *(const LAS f32x4*)(wv + 64 + 32 * u + 4 * fq), ds1 = *(const LAS f32x4*)(wv + 64 + 32 * u + 16 + 4 * fq);
#pragma unroll
            for (int j = 0; j < 4; ++j) { const int l = 16 * j + fr; float m0[4], m1[4];
#pragma unroll
                for (int r = 0; r < 4; ++r) { const int s0 = 32 * u + 4 * fq + r, s1 = s0 + 16;
                    m0[r] = (s0 <= l) ? cbt[2 * u][j][r] * __expf(acl[j] - as0[r]) * ds0[r] : 0.f;
                    m1[r] = (s1 <= l) ? cbt[2 * u + 1][j][r] * __expf(acl[j] - as1[r]) * ds1[r] : 0.f; }
                u32x4 pk; pk.x = cvt_pk_bf16(m0[0], m0[1]); pk.y = cvt_pk_bf16(m0[2], m0[3]); pk.z = cvt_pk_bf16(m1[0], m1[1]); pk.w = cvt_pk_bf16(m1[2], m1[3]);
                mt[j][u] = __builtin_bit_cast(bf16x8, pk); }
        }
    }
    {
        f32x4 yd[4][4];
#pragma unroll
        for (int i = 0; i < 4; ++i)
#pragma unroll
            for (int j = 0; j < 4; ++j) yd[i][j] = (f32x4){0.f, 0.f, 0.f, 0.f};
        const unsigned xa = lbase + L_XS + ((lane & 15) >> 2) * XS_STRIDE + (w * 64 + 4 * (lane & 3)) * 2;
#pragma unroll
        for (int u = 0; u < 2; ++u)
#pragma unroll
            for (int i = 0; i < 4; ++i) { u32x2 r0, r1; const unsigned ad = xa + (32 * u + 4 * fq) * XS_STRIDE + 32 * i; tr_read2(ad, ad + 16 * XS_STRIDE, r0, r1); const bf16x8 xf = mk_frag(r0, r1);
#pragma unroll
                for (int j = 0; j < 4; ++j) yd[i][j] = __builtin_amdgcn_mfma_f32_16x16x32_bf16(xf, mt[j][u], yd[i][j], 0, 0, 0); }
        float* yo = Y0 + ((size_t)(c * H + h) * 16) * 256 + lane * 4;
#pragma unroll
        for (int i = 0; i < 4; ++i)
#pragma unroll
            for (int j = 0; j < 4; ++j) { const u32x2 xv = *(const LAS u32x2*)(lds + L_XS + (16 * j + fr) * XS_STRIDE + (w * 64 + 16 * i + 4 * fq) * 2);
                f32x4 o = yd[i][j]; o.x = fmaf(Dh, bf_lo(xv.x), o.x); o.y = fmaf(Dh, bf_hi(xv.x), o.y); o.z = fmaf(Dh, bf_lo(xv.y), o.z); o.w = fmaf(Dh, bf_hi(xv.y), o.w);
                *(f32x4*)(yo + (i * 4 + j) * 256) = o; }
    }
    {
        bf16x8 xw[4][2];
        const unsigned xa = lbase + L_XS + ((lane & 15) >> 2) * XS_STRIDE + (w * 64 + 4 * (lane & 3)) * 2;
#pragma unroll
        for (int ks = 0; ks < 2; ++ks) {
            const f32x4 w0 = *(const LAS f32x4*)(wv + 128 + 32 * ks + 8 * fq), w1 = *(const LAS f32x4*)(wv + 128 + 32 * ks + 8 * fq + 4);
#pragma unroll
            for (int i = 0; i < 4; ++i) { u32x2 r0, r1; const unsigned ad = xa + (32 * ks + 8 * fq) * XS_STRIDE + 32 * i; tr_read2(ad, ad + 4 * XS_STRIDE, r0, r1);
                u32x4 pk; pk.x = cvt_pk_bf16(bf_lo(r0.x) * w0.x, bf_hi(r0.x) * w0.y); pk.y = cvt_pk_bf16(bf_lo(r0.y) * w0.z, bf_hi(r0.y) * w0.w);
                pk.z = cvt_pk_bf16(bf_lo(r1.x) * w1.x, bf_hi(r1.x) * w1.y); pk.w = cvt_pk_bf16(bf_lo(r1.y) * w1.z, bf_hi(r1.y) * w1.w);
                xw[i][ks] = __builtin_bit_cast(bf16x8, pk); }
        }
        const unsigned ba = lbase + L_BS + ((lane & 15) >> 2) * BS_STRIDE + (4 * (lane & 3)) * 2;
        u32x2* so = (u32x2*)(SC + ((size_t)(c * H + h) * 32) * 256) + lane;
#pragma unroll
        for (int nt = 0; nt < 8; ++nt) {
            f32x4 sc[4];
#pragma unroll
            for (int i = 0; i < 4; ++i) sc[i] = (f32x4){0.f, 0.f, 0.f, 0.f};
#pragma unroll
            for (int ks = 0; ks < 2; ++ks) { u32x2 r0, r1; const unsigned ad = ba + (32 * ks + 8 * fq) * BS_STRIDE + 32 * nt; tr_read2(ad, ad + 4 * BS_STRIDE, r0, r1); const bf16x8 bt = mk_frag(r0, r1);
#pragma unroll
                for (int i = 0; i < 4; ++i) sc[i] = __builtin_amdgcn_mfma_f32_16x16x32_bf16(bt, xw[i][ks], sc[i], 0, 0, 0); }
#pragma unroll
            for (int i = 0; i < 4; ++i) { u32x2 o; o.x = cvt_pk_bf16(sc[i].x, sc[i].y); o.y = cvt_pk_bf16(sc[i].z, sc[i].w); so[(nt * 4 + i) * 64] = o; }
        }
    }
    __syncthreads();
}

__device__ __forceinline__ void ssd_scan(const Frame& F, const Args& a) {
    if (F.tid >= 256) return;
    const unsigned* SC = (const unsigned*)(a.ws + WS_SC); unsigned* PV = (unsigned*)(a.ws + WS_PREV); const float* DEC = (const float*)(a.ws + WS_DEC);
    const int i = F.vcu * 256 + F.tid;
    if (i >= 65536) return;
    const int h = i >> 12;
    float c0 = 0.f, c1 = 0.f;
    for (int cb = 0; cb < NCH; cb += 16) {
        unsigned sv[16]; float dv[16];
#pragma unroll
        for (int k = 0; k < 16; ++k) { sv[k] = SC[(size_t)(cb + k) * 65536 + i]; dv[k] = DEC[(cb + k) * H + h]; }
#pragma unroll
        for (int k = 0; k < 16; ++k) { PV[(size_t)(cb + k) * 65536 + i] = cvt_pk_bf16(c0, c1); c0 = fmaf(c0, dv[k], bf_lo(sv[k])); c1 = fmaf(c1, dv[k], bf_hi(sv[k])); }
    }
}

__device__ __forceinline__ void ssd_c_unit(const Frame& F, const Args& a, int c, int g) {
    const bf16_t* PROJ = (const bf16_t*)(a.ws + WS_PROJ); const float* ACUM = (const float*)(a.ws + WS_ACUM); const bf16_t* CC = (const bf16_t*)(a.ws + WS_CC);
    const float* Y0 = (const float*)(a.ws + WS_Y0); const bf16_t* PV = (const bf16_t*)(a.ws + WS_PREV); bf16_t* MIX = (bf16_t*)(a.ws + WS_MIX); const float* g_ssm = a.in[8];
    const int t0 = c * CL, lane = F.lane, w = F.wave, h = g * 8 + w, fr = lane & 15, fq = lane >> 4;
    LAS float* red = (LAS float*)(F.lds);
    f32x4 yo[4][4];
#pragma unroll
    for (int i = 0; i < 4; ++i)
#pragma unroll
        for (int j = 0; j < 4; ++j) yo[i][j] = (f32x4){0.f, 0.f, 0.f, 0.f};
    const u32x2* pv = (const u32x2*)(PV + ((size_t)(c * H + h) * 32) * 256) + lane;
#pragma unroll
    for (int u = 0; u < 4; ++u) { bf16x8 pf[4], cf[4];
#pragma unroll
        for (int i = 0; i < 4; ++i) pf[i] = mk_frag(pv[((2 * u) * 4 + i) * 64], pv[((2 * u + 1) * 4 + i) * 64]);
#pragma unroll
        for (int j = 0; j < 4; ++j) { const bf16_t* cp = CC + (size_t)(t0 + 16 * j + fr) * 256 + g * 128 + 32 * u + 4 * fq; cf[j] = mk_frag(*(const u32x2*)cp, *(const u32x2*)(cp + 16)); }
#pragma unroll
        for (int i = 0; i < 4; ++i)
#pragma unroll
            for (int j = 0; j < 4; ++j) yo[i][j] = __builtin_amdgcn_mfma_f32_16x16x32_bf16(pf[i], cf[j], yo[i][j], 0, 0, 0); }
    const float* y0 = Y0 + ((size_t)(c * H + h) * 16) * 256 + lane * 4;
    float ssq[4];
#pragma unroll
    for (int j = 0; j < 4; ++j) { const int t = t0 + 16 * j + fr; const float ea = __expf(ACUM[(size_t)t * H + h]); float sq = 0.f;
#pragma unroll
        for (int i = 0; i < 4; ++i) { const f32x4 b = *(const f32x4*)(y0 + (i * 4 + j) * 256); const u32x2 zv = *(const u32x2*)(PROJ + (size_t)t * NPJ + C_Z + h * HD + 16 * i + 4 * fq);
            f32x4 y; y.x = fmaf(ea, yo[i][j].x, b.x) * silu_fast(bf_lo(zv.x)); y.y = fmaf(ea, yo[i][j].y, b.y) * silu_fast(bf_hi(zv.x)); y.z = fmaf(ea, yo[i][j].z, b.z) * silu_fast(bf_lo(zv.y)); y.w = fmaf(ea, yo[i][j].w, b.w) * silu_fast(bf_hi(zv.y));
            yo[i][j] = y; sq += (y.x * y.x + y.y * y.y) + (y.z * y.z + y.w * y.w); }
        sq += __shfl_xor(sq, 16); sq += __shfl_xor(sq, 32); ssq[j] = sq; }
    if (fq == 0) {
#pragma unroll
        for (int j = 0; j < 4; ++j) red[(16 * j + fr) * 8 + w] = ssq[j]; }
    __syncthreads();
#pragma unroll
    for (int j = 0; j < 4; ++j) { const f32x4 r0 = *(const LAS f32x4*)(red + (16 * j + fr) * 8), r1 = *(const LAS f32x4*)(red + (16 * j + fr) * 8 + 4);
        const float tot = ((r0.x + r0.y) + (r0.z + r0.w)) + ((r1.x + r1.y) + (r1.z + r1.w)); const float rs = rsqrtf(tot * (1.f / 512.f) + EPS);
        const int t = t0 + 16 * j + fr;
#pragma unroll
        for (int i = 0; i < 4; ++i) { const int col = h * HD + 16 * i + 4 * fq; const f32x4 gs = *(const f32x4*)(g_ssm + col); const f32x4 y = yo[i][j];
            u32x2 o; o.x = cvt_pk_bf16(y.x * rs * gs.x, y.y * rs * gs.y); o.y = cvt_pk_bf16(y.z * rs * gs.z, y.w * rs * gs.w);
            *(u32x2*)(MIX + (size_t)t * D + 1024 + col) = o; } }
    __syncthreads();
}

constexpr int VT_STRIDE = 144, VT_BYTES = 64 * VT_STRIDE;
__device__ __forceinline__ void attn_unit(const Frame& F, const Args& a, int h, int t0) {
    const bf16_t* PROJ = (const bf16_t*)(a.ws + WS_PROJ); bf16_t* MIX = (bf16_t*)(a.ws + WS_MIX);
    const int lane = fresh_lane(), fr = lane & 15, fq = lane >> 4;
    LAS unsigned char* vt = F.lds + F.wave * VT_BYTES;
    const unsigned vrd = (unsigned)(uintptr_t)vt + ((lane & 15) >> 2) * VT_STRIDE + 4 * (lane & 3) * 2 + 4 * fq * VT_STRIDE;
    bf16x8 qf[2][2];
#pragma unroll
    for (int qt = 0; qt < 2; ++qt)
#pragma unroll
        for (int kk = 0; kk < 2; ++kk) qf[qt][kk] = *(const bf16x8*)(PROJ + (size_t)(t0 + 16 * qt + fr) * NPJ + h * HD + 32 * kk + 8 * fq);
    bf16x8 Ua, Ub, Uones;
    { u32x4 ua, ub;
      unsigned e[8], g[8];
#pragma unroll
      for (int j = 0; j < 8; ++j) { const int sp = (j < 4) ? (4 * fq + j) : (16 + 4 * fq + (j - 4)); e[j] = (sp >= fr) ? 0x3F80u : 0u; g[j] = (sp >= 16 + fr) ? 0x3F80u : 0u; }
      ua.x = e[0] | (e[1] << 16); ua.y = e[2] | (e[3] << 16); ua.z = e[4] | (e[5] << 16); ua.w = e[6] | (e[7] << 16);
      ub.x = g[0] | (g[1] << 16); ub.y = g[2] | (g[3] << 16); ub.z = g[4] | (g[5] << 16); ub.w = g[6] | (g[7] << 16);
      Ua = __builtin_bit_cast(bf16x8, ua); Ub = __builtin_bit_cast(bf16x8, ub); const u32x4 on = {0x3F803F80u, 0x3F803F80u, 0x3F803F80u, 0x3F803F80u}; Uones = __builtin_bit_cast(bf16x8, on); }
    f32x4 o[4][2];
#pragma unroll
    for (int i = 0; i < 4; ++i)
#pragma unroll
        for (int j = 0; j < 2; ++j) o[i][j] = (f32x4){0.f, 0.f, 0.f, 0.f};
    float carry[2] = {0.f, 0.f};
    const f32x4 z4 = {0.f, 0.f, 0.f, 0.f};
    const int sd = t0 & ~63;
    for (int s0 = sd; s0 >= 0; s0 -= 64) {
        bf16x8 kf[4][2];
#pragma unroll
        for (int st = 0; st < 4; ++st)
#pragma unroll
            for (int kk = 0; kk < 2; ++kk) kf[st][kk] = *(const bf16x8*)(PROJ + (size_t)(s0 + 16 * st + fr) * NPJ + C_K + h * HD + 32 * kk + 8 * fq);
        { u32x4 vv[8];
#pragma unroll
          for (int i = 0; i < 8; ++i) vv[i] = *(const u32x4*)(PROJ + (size_t)(s0 + (lane >> 3) + 8 * i) * NPJ + C_V + h * HD + (lane & 7) * 8);
#pragma unroll
          for (int i = 0; i < 8; ++i) *(LAS u32x4*)(vt + ((lane >> 3) + 8 * i) * VT_STRIDE + (lane & 7) * 16) = vv[i]; }
        LDS_WAIT();
        const bool diag = (s0 == sd);
#pragma unroll
        for (int qt = 0; qt < 2; ++qt) {
            const int lim = diag ? (t0 - sd + 16 * qt + fr) : 4096;
            f32x4 sx[4];
#pragma unroll
            for (int st = 0; st < 4; ++st) { sx[st] = __builtin_amdgcn_mfma_f32_16x16x32_bf16(kf[st][0], qf[qt][0], z4, 0, 0, 0); sx[st] = __builtin_amdgcn_mfma_f32_16x16x32_bf16(kf[st][1], qf[qt][1], sx[st], 0, 0, 0); }
            float lk[4][4]; float tot = 0.f;
#pragma unroll
            for (int st = 0; st < 4; ++st)
#pragma unroll
                for (int r = 0; r < 4; ++r) { const float x = sx[st][r] * 0.125f; sx[st][r] = x;
                    const float sp = fmaxf(x, 0.f) + __logf(1.f + __expf(-fabsf(x)));
                    const float v = (16 * st + 4 * fq + r < lim) ? -sp : 0.f; lk[st][r] = v; tot += v; }
            bf16x8 hi[2], lo[2];
#pragma unroll
            for (int u = 0; u < 2; ++u) { u32x4 ph, pl; float rs[8];
#pragma unroll
                for (int r = 0; r < 4; ++r) { rs[r] = lk[2 * u][r]; rs[4 + r] = lk[2 * u + 1][r]; }
                ph.x = cvt_pk_bf16(rs[0], rs[1]); ph.y = cvt_pk_bf16(rs[2], rs[3]); ph.z = cvt_pk_bf16(rs[4], rs[5]); ph.w = cvt_pk_bf16(rs[6], rs[7]);
                pl.x = cvt_pk_bf16(rs[0] - bf_lo(ph.x), rs[1] - bf_hi(ph.x)); pl.y = cvt_pk_bf16(rs[2] - bf_lo(ph.y), rs[3] - bf_hi(ph.y));
                pl.z = cvt_pk_bf16(rs[4] - bf_lo(ph.z), rs[5] - bf_hi(ph.z)); pl.w = cvt_pk_bf16(rs[6] - bf_lo(ph.w), rs[7] - bf_hi(ph.w));
                hi[u] = __builtin_bit_cast(bf16x8, ph); lo[u] = __builtin_bit_cast(bf16x8, pl); }
            f32x4 suf[4];
            suf[0] = __builtin_amdgcn_mfma_f32_16x16x32_bf16(Ua, hi[0], z4, 0, 0, 0); suf[0] = __builtin_amdgcn_mfma_f32_16x16x32_bf16(Ua, lo[0], suf[0], 0, 0, 0);
            suf[0] = __builtin_amdgcn_mfma_f32_16x16x32_bf16(Uones, hi[1], suf[0], 0, 0, 0); suf[0] = __builtin_amdgcn_mfma_f32_16x16x32_bf16(Uones, lo[1], suf[0], 0, 0, 0);
            suf[1] = __builtin_amdgcn_mfma_f32_16x16x32_bf16(Ub, hi[0], z4, 0, 0, 0); suf[1] = __builtin_amdgcn_mfma_f32_16x16x32_bf16(Ub, lo[0], suf[1], 0, 0, 0);
            suf[1] = __builtin_amdgcn_mfma_f32_16x16x32_bf16(Uones, hi[1], suf[1], 0, 0, 0); suf[1] = __builtin_amdgcn_mfma_f32_16x16x32_bf16(Uones, lo[1], suf[1], 0, 0, 0);
            suf[2] = __builtin_amdgcn_mfma_f32_16x16x32_bf16(Ua, hi[1], z4, 0, 0, 0); suf[2] = __builtin_amdgcn_mfma_f32_16x16x32_bf16(Ua, lo[1], suf[2], 0, 0, 0);
            suf[3] = __builtin_amdgcn_mfma_f32_16x16x32_bf16(Ub, hi[1], z4, 0, 0, 0); suf[3] = __builtin_amdgcn_mfma_f32_16x16x32_bf16(Ub, lo[1], suf[3], 0, 0, 0);
            tot += __shfl_xor(tot, 16); tot += __shfl_xor(tot, 32);
            bf16x8 wf[2];
#pragma unroll
            for (int u = 0; u < 2; ++u) { float wv[8];
#pragma unroll
                for (int r = 0; r < 4; ++r) {
                    wv[r] = (16 * (2 * u) + 4 * fq + r < lim) ? __expf(sx[2 * u][r] + suf[2 * u][r] + carry[qt]) : 0.f;
                    wv[4 + r] = (16 * (2 * u + 1) + 4 * fq + r < lim) ? __expf(sx[2 * u + 1][r] + suf[2 * u + 1][r] + carry[qt]) : 0.f; }
                u32x4 pw; pw.x = cvt_pk_bf16(wv[0], wv[1]); pw.y = cvt_pk_bf16(wv[2], wv[3]); pw.z = cvt_pk_bf16(wv[4], wv[5]); pw.w = cvt_pk_bf16(wv[6], wv[7]);
                wf[u] = __builtin_bit_cast(bf16x8, pw); }
#pragma unroll
            for (int u = 0; u < 2; ++u) { u32x2 rr[8]; const unsigned ad = vrd + 32 * u * VT_STRIDE; tr_read8(ad, ad + 16 * VT_STRIDE, rr);
#pragma unroll
                for (int dt = 0; dt < 4; ++dt) o[dt][qt] = __builtin_amdgcn_mfma_f32_16x16x32_bf16(mk_frag(rr[2 * dt], rr[2 * dt + 1]), wf[u], o[dt][qt], 0, 0, 0); }
            carry[qt] += tot;
        }
        const float cm = fmaxf(carry[0], carry[1]);
        if (__all(cm < -104.f)) break;
    }
#pragma unroll
    for (int qt = 0; qt < 2; ++qt)
#pragma unroll
        for (int dt = 0; dt < 4; ++dt) { u32x2 w; w.x = cvt_pk_bf16(o[dt][qt].x, o[dt][qt].y); w.y = cvt_pk_bf16(o[dt][qt].z, o[dt][qt].w);
            *(u32x2*)(MIX + (size_t)(t0 + 16 * qt + fr) * D + h * HD + 16 * dt + 4 * fq) = w; }
}

__device__ __forceinline__ void p2_mix(const Frame& F, const Args& a, int qoff = 0) {
    unsigned* ctl = (unsigned*)(a.ws + WS_CTL) + qoff;
    for (int u = F.vcu; u < NCH * 2; u += F.G) ssd_a_unit(F, a, u >> 1, u & 1);
    for (;;) {
        int u = 0; if (F.lane == 0) u = (int)__hip_atomic_fetch_add(ctl + CW_ATTQ, 1u, RLX_AGENT);
        u = __builtin_amdgcn_readfirstlane(u);
        if (u >= H * (S / 32)) break;
        const int blk = (S / 32 - 1) - (u / H), h = u % H;
        attn_unit(F, a, h, blk * 32);
    }
}

typedef float f32x16 __attribute__((ext_vector_type(16)));
__device__ __forceinline__ void p6_router(const Frame& F, const Args& a) {
    const float* X2 = (const float*)(a.ws + WS_X2); bf16_t* H2 = (bf16_t*)(a.ws + WS_H2); const float* g_ffn = a.in[10]; const float* wr = a.in[11]; const float* br = a.in[12];
    unsigned* cnt = (unsigned*)(a.ws + WS_CTL) + CW_CNT; int* tokof = (int*)(a.ws + WS_TOKOF); int* TE = (int*)(a.ws + WS_TE); int* TP = (int*)(a.ws + WS_TP); float* TG = (float*)(a.ws + WS_TG);
    const int lane = fresh_lane(), w = F.wave;
    LAS float* part = (LAS float*)F.lds;
    LAS float* rs = (LAS float*)(F.lds + 32768);
    LAS float* lg = (LAS float*)(F.lds + 32768 + 128);
    for (int rb = F.vcu; rb < S / 32; rb += F.G) {
        const int row0 = rb * 32;
#pragma unroll 1
        for (int rr = 0; rr < 4; ++rr) { const int t = row0 + 4 * w + rr;
            f32x4 v[8]; const float r = rms_load(X2 + (size_t)t * D, lane, v);
            const f32x4* gp = (const f32x4*)g_ffn + lane; u32x2* o8 = (u32x2*)(H2 + (size_t)t * D) + lane;
#pragma unroll
            for (int j = 0; j < 8; ++j) { const f32x4 g = gp[64 * j]; u32x2 o; o.x = cvt_pk_bf16(v[j].x * r * g.x, v[j].y * r * g.y); o.y = cvt_pk_bf16(v[j].z * r * g.z, v[j].w * r * g.w); o8[64 * j] = o; }
            if (lane == 0) rs[4 * w + rr] = r; }
        f32x16 acc;
#pragma unroll
        for (int i = 0; i < 16; ++i) acc[i] = 0.f;
        const int i32 = lane & 31, hh = lane >> 5;
        const float* xp = X2 + (size_t)(row0 + i32) * D + 256 * w + 4 * hh; const float* gq = g_ffn + 256 * w + 4 * hh; const float* wp = wr + (size_t)(256 * w + 4 * hh) * NE + i32;
#pragma unroll 4
        for (int kk = 0; kk < 32; ++kk) { const f32x4 xv = *(const f32x4*)(xp + 8 * kk), gv = *(const f32x4*)(gq + 8 * kk);
            const float b0 = wp[(size_t)(8 * kk + 0) * NE], b1 = wp[(size_t)(8 * kk + 1) * NE], b2 = wp[(size_t)(8 * kk + 2) * NE], b3 = wp[(size_t)(8 * kk + 3) * NE];
            acc = __builtin_amdgcn_mfma_f32_32x32x2f32(xv.x * gv.x, b0, acc, 0, 0, 0); acc = __builtin_amdgcn_mfma_f32_32x32x2f32(xv.y * gv.y, b1, acc, 0, 0, 0);
            acc = __builtin_amdgcn_mfma_f32_32x32x2f32(xv.z * gv.z, b2, acc, 0, 0, 0); acc = __builtin_amdgcn_mfma_f32_32x32x2f32(xv.w * gv.w, b3, acc, 0, 0, 0); }
#pragma unroll
        for (int r = 0; r < 16; ++r) part[(w * 32 + ((r & 3) + 8 * (r >> 2) + 4 * hh)) * 32 + i32] = acc[r];
        __syncthreads();
        for (int q = F.tid; q < 1024; q += NT) { const int i = q >> 5, e = q & 31; float sacc = 0.f;
#pragma unroll
            for (int ww = 0; ww < 8; ++ww) sacc += part[(ww * 32 + i) * 32 + e];
            lg[i * 33 + e] = sacc * rs[i] + br[e]; }
        __syncthreads();
        if (F.tid < 32) { const int t = row0 + F.tid; LAS float* L = lg + F.tid * 33;
            int sel[4]; float sv[4];
#pragma unroll
            for (int k = 0; k < 4; ++k) { float bv = -3.4e38f; int bi = 0;
                for (int e = 0; e < 32; ++e) { const float x = L[e]; if (x > bv) { bv = x; bi = e; } }
                L[bi] = -3.4e38f; sel[k] = bi; sv[k] = bv; }
            const float e1 = expf(sv[1] - sv[0]), e2 = expf(sv[2] - sv[0]), e3 = expf(sv[3] - sv[0]); const float inv = 1.f / (1.f + e1 + e2 + e3);
            const float gg[4] = {inv, e1 * inv, e2 * inv, e3 * inv};
#pragma unroll
            for (int k = 0; k < 4; ++k) { const int pos = (int)__hip_atomic_fetch_add(cnt + sel[k], 1u, RLX_AGENT);
                tokof[sel[k] * ECAP + pos] = t; TE[t * 4 + k] = sel[k]; TP[t * 4 + k] = pos; TG[t * 4 + k] = gg[k]; } }
        __syncthreads();
    }
}

__device__ __forceinline__ void moe_tables(const Frame& F, const Args& a, int ntn) {
    LAS int* T = (LAS int*)(F.lds + LDSCTL_OFF);
    unsigned* cnt = (unsigned*)(a.ws + WS_CTL) + CW_CNT;
    __syncthreads();
    if (F.tid == 0) { int pu = 0, po = 0;
        for (int e = 0; e < NE; ++e) { const int c = (int)__hip_atomic_load(cnt + e, RLX_AGENT); const int mt = (c + 255) >> 8; T[L_CNT + e] = c; T[L_PFXU + e] = pu; T[L_POFF + e] = po; pu += mt * ntn; po += mt * 256; }
        T[L_PFXU + NE] = pu; T[L_POFF + NE] = po; }
    __syncthreads();
}

__device__ __forceinline__ void p9_final(const Frame& F, const Args& a) {
    const float* X2 = (const float*)(a.ws + WS_X2); const bf16_t* YS = (const bf16_t*)(a.ws + WS_YS); const int* TE = (const int*)(a.ws + WS_TE); const int* TP = (const int*)(a.ws + WS_TP); const float* TG = (const float*)(a.ws + WS_TG);
    const float* g_final = a.in[17]; const LAS int* T = (const LAS int*)(F.lds + LDSCTL_OFF);
    const int gw = F.vcu * NWAVES + F.wave, NGW = F.G * NWAVES;
    for (int t = gw; t < S; t += NGW) {
        f32x4 v[8]; const f32x4* xr = (const f32x4*)(X2 + (size_t)t * D) + F.lane;
#pragma unroll
        for (int j = 0; j < 8; ++j) v[j] = xr[64 * j];
#pragma unroll
        for (int k = 0; k < 4; ++k) { const int e = TE[t * 4 + k], pos = TP[t * 4 + k]; const float g = TG[t * 4 + k];
            const u32x2* yp = (const u32x2*)(YS + (size_t)(T[L_POFF + e] + pos) * D) + F.lane;
#pragma unroll
            for (int j = 0; j < 8; ++j) { const u32x2 y = yp[64 * j]; v[j].x = fmaf(g, bf_lo(y.x), v[j].x); v[j].y = fmaf(g, bf_hi(y.x), v[j].y); v[j].z = fmaf(g, bf_lo(y.y), v[j].z); v[j].w = fmaf(g, bf_hi(y.y), v[j].w); } }
        float s = 0.f;
#pragma unroll
        for (int j = 0; j < 8; ++j) s += (v[j].x * v[j].x + v[j].y * v[j].y) + (v[j].z * v[j].z + v[j].w * v[j].w);
        const float r = rsqrtf(wave_sum(s) * (1.f / D) + EPS);
        const f32x4* gp = (const f32x4*)g_final + F.lane; f32x4* op = (f32x4*)(a.out + (size_t)t * D) + F.lane;
#pragma unroll
        for (int j = 0; j < 8; ++j) { const f32x4 g = gp[64 * j]; f32x4 o; o.x = v[j].x * r * g.x; o.y = v[j].y * r * g.y; o.z = v[j].z * r * g.z; o.w = v[j].w * r * g.w; op[64 * j] = o; }
    }
}

constexpr int NPHASE = 10;
__global__ void __launch_bounds__(NT, 2) mk_fwd(Args args) {
    extern __shared__ __attribute__((aligned(16))) unsigned char lds_raw[];
    Frame F; F.lds = (LAS unsigned char*)lds_raw; F.tid = threadIdx.x; F.lane = F.tid & 63; F.wave = __builtin_amdgcn_readfirstlane(F.tid >> 6);
    F.G = gridDim.x; { const int bx = blockIdx.x; F.vcu = (F.G % 8 == 0) ? (bx % 8) * (F.G / 8) + bx / 8 : bx; }
    unsigned char* ws = args.ws;
    for (int u = F.tid; u < (LDS_BYTES - LDSCTL_OFF) / 4; u += NT) ((LAS unsigned*)(F.lds + LDSCTL_OFF))[u] = 0u;
    __syncthreads();
    XcdBarrier bar; bar.bar = (unsigned*)(ws + WS_CTL) + CW_BAR; bar.x = 0; bar.st = nullptr;
    if (!MK_SPLIT) bar = xcd_barrier_post((unsigned*)(ws + WS_CTL) + CW_BAR, (volatile LAS unsigned*)(F.lds + LDSCTL_OFF) + L_MISC + 8);
    const int lo = args.ph_lo, hi = args.ph_hi;
#define IN(k) (lo <= (k) && (k) < hi)
#define SEAM(k) do { if (IN(k) && IN((k) + 1)) xcd_barrier(bar); } while (0)
    const LAS int* T = (const LAS int*)(F.lds + LDSCTL_OFF);
    if (IN(0)) { p0_prologue(F, args); if (PROBE_REP & 1) { xcd_barrier(bar); p0_prologue(F, args); } } SEAM(0);
    if (IN(1)) { pg8::NatOrder So; So.init(ws + WS_XN, ws + WS_WIN, S, NPAD, F.G, (int)blockIdx.x); pg8::EpiProj E{(bf16_t*)(ws + WS_PROJ), (float*)(ws + WS_DT)};
        pg8::gemm_phase<pg8::EpiProj, pg8::NatOrder>(F.lds, So, E); if (PROBE_REP & 2) { xcd_barrier(bar); pg8::gemm_phase<pg8::EpiProj, pg8::NatOrder>(F.lds, So, E); } } SEAM(1);
    if (IN(2)) { p2_mix(F, args); if (PROBE_REP & 4) { xcd_barrier(bar); p2_mix(F, args, 64); } } SEAM(2);
    if (IN(3)) { ssd_scan(F, args); if (PROBE_REP & 8) { xcd_barrier(bar); ssd_scan(F, args); } } SEAM(3);
    if (IN(4)) { for (int u = F.vcu; u < NCH * 2; u += F.G) ssd_c_unit(F, args, u >> 1, u & 1); if (PROBE_REP & 16) { xcd_barrier(bar); for (int u = F.vcu; u < NCH * 2; u += F.G) ssd_c_unit(F, args, u >> 1, u & 1); } } SEAM(4);
    if (IN(5)) { pg8::NatOrder So; So.init(ws + WS_MIX, ws + WS_WOUT, S, D, F.G, (int)blockIdx.x); pg8::EpiRes E{args.in[0], (float*)(ws + WS_X2)};
        pg8::gemm_phase<pg8::EpiRes, pg8::NatOrder>(F.lds, So, E); } SEAM(5);
    if (IN(6)) { p6_router(F, args); } SEAM(6);
    if (IN(7)) { moe_tables(F, args, 16);
        pg8::MoeOrder<true> So{(const char*)(ws + WS_H2), (const char*)(ws + WS_WGU), (const int*)(ws + WS_TOKOF), T + L_CNT, T + L_PFXU, T + L_POFF, 16, F.G, F.vcu};
        pg8::EpiGU E{(bf16_t*)(ws + WS_ACT), args.in[14], T + L_POFF};
        pg8::gemm_phase<pg8::EpiGU, pg8::MoeOrder<true>>(F.lds, So, E); if (PROBE_REP & 128) { xcd_barrier(bar); pg8::gemm_phase<pg8::EpiGU, pg8::MoeOrder<true>>(F.lds, So, E); } } SEAM(7);
    if (IN(8)) { moe_tables(F, args, 8);
        pg8::MoeOrder<false> So{(const char*)(ws + WS_ACT), (const char*)(ws + WS_WDN), nullptr, T + L_CNT, T + L_PFXU, T + L_POFF, 8, F.G, F.vcu};
        pg8::EpiDown E{(bf16_t*)(ws + WS_YS), args.in[16], T + L_POFF};
        pg8::gemm_phase<pg8::EpiDown, pg8::MoeOrder<false>>(F.lds, So, E); if (PROBE_REP & 256) { xcd_barrier(bar); pg8::gemm_phase<pg8::EpiDown, pg8::MoeOrder<false>>(F.lds, So, E); } } SEAM(8);
    if (IN(9)) { moe_tables(F, args, 8); p9_final(F, args); if (PROBE_REP & 512) { xcd_barrier(bar); p9_final(F, args); } }
#undef IN
#undef SEAM
}

extern "C" void kernel_launch(void* const* d_in, const int* in_sizes, int n_in, void* d_out, int out_size, void* d_ws, size_t ws_size, hipStream_t stream) {
    static int grid = 0;
    if (grid == 0) {
        if (n_in != 18 || out_size != S * D || ws_size < WS_END) { fprintf(stderr, "kernel_launch: unexpected problem (n_in %d out %d ws %zu need %zu)\n", n_in, out_size, ws_size, (size_t)WS_END); grid = -1; return; }
        int dev = 0, cus = 0, per_cu = 0;
        if (hipGetDevice(&dev) != hipSuccess || hipDeviceGetAttribute(&cus, hipDeviceAttributeMultiprocessorCount, dev) != hipSuccess) { grid = -1; return; }
        if (hipFuncSetAttribute((const void*)mk_fwd, hipFuncAttributeMaxDynamicSharedMemorySize, LDS_BYTES) != hipSuccess) { fprintf(stderr, "kernel_launch: hipFuncSetAttribute failed\n"); grid = -1; return; }
        if (hipOccupancyMaxActiveBlocksPerMultiprocessor(&per_cu, (const void*)mk_fwd, NT, LDS_BYTES) != hipSuccess || per_cu < 1) { fprintf(stderr, "kernel_launch: occupancy query says %d\n", per_cu); }
        (void)hipGetLastError();
        grid = cus;
    }
    if (grid < 0) return;
    if (hipMemsetAsync((char*)d_ws + WS_CTL, 0, CTL_ZERO_BYTES, stream) != hipSuccess) return;
    Args a; memset(&a, 0, sizeof a);
    for (int i = 0; i < 18; ++i) a.in[i] = (const float*)d_in[i];
    a.out = (float*)d_out; a.ws = (unsigned char*)d_ws;
#if MK_SPLIT
    for (int p = 0; p < NPHASE; ++p) { a.ph_lo = p; a.ph_hi = p + 1; hipLaunchKernelGGL(mk_fwd, dim3(grid), dim3(NT), LDS_BYTES, stream, a); }
#else
    a.ph_lo = 0; a.ph_hi = NPHASE; hipLaunchKernelGGL(mk_fwd, dim3(grid), dim3(NT), LDS_BYTES, stream, a);
#endif
}
```

```cpp
#include <hip/hip_runtime.h>
#include <cstdio>
#include <cstdint>
#include <cstring>

#ifndef MK_SPLIT
#define MK_SPLIT 0
#endif

#ifndef PROBE_REP
#define PROBE_REP 0
#endif
#define LAS __attribute__((address_space(3)))
#define GAS __attribute__((address_space(1)))
typedef unsigned short bf16_t;
typedef short bf16x8 __attribute__((ext_vector_type(8)));
typedef float f32x4 __attribute__((ext_vector_type(4)));
typedef float f32x2 __attribute__((ext_vector_type(2)));
typedef unsigned u32x4 __attribute__((ext_vector_type(4)));
typedef unsigned u32x2 __attribute__((ext_vector_type(2)));

constexpr int S = 8192, D = 2048, H = 16, HD = 64, NE = 32, DFF = 2048;
constexpr int NPJ = 5632;
constexpr int NPAD = 5888;
constexpr int NPROJ = 5648;
constexpr int C_K = 1024, C_V = 2048, C_Z = 3072, C_XBC = 4096;
constexpr int XBC = 1536, NST = 128, NCH = 128, CL = 64;
constexpr float EPS = 1e-5f;
constexpr int ECAP = 8192;
constexpr int MAXROWS = S * 4 + NE * 256;

constexpr size_t MiB = 1u << 20;
constexpr size_t WS_CTL = 0, CTL_ZERO_BYTES = 1 * MiB;
constexpr size_t WS_WIN = 2 * MiB;
constexpr size_t WS_WOUT = WS_WIN + (size_t)NPAD * D * 2;
constexpr size_t WS_WGU = WS_WOUT + (size_t)D * D * 2;
constexpr size_t WS_WDN = WS_WGU + (size_t)NE * 2 * DFF * D * 2;
constexpr size_t WS_XN = WS_WDN + (size_t)NE * D * DFF * 2;
constexpr size_t WS_PROJ = WS_XN + (size_t)S * D * 2;
constexpr size_t WS_DT = WS_PROJ + (size_t)S * NPJ * 2;
constexpr size_t WS_ACUM = WS_DT + (size_t)S * H * 4;
constexpr size_t WS_DEC = WS_ACUM + (size_t)S * H * 4;
constexpr size_t WS_CC = WS_DEC + (size_t)NCH * H * 4;
constexpr size_t WS_Y0 = WS_CC + (size_t)S * 256 * 2;
constexpr size_t WS_SC = WS_Y0 + (size_t)S * 1024 * 4;
constexpr size_t WS_PREV = WS_SC + (size_t)NCH * H * 8192 * 2;
constexpr size_t WS_MIX = WS_PREV + (size_t)NCH * H * 8192 * 2;
constexpr size_t WS_X2 = WS_MIX + (size_t)S * D * 2;
constexpr size_t WS_H2 = WS_X2 + (size_t)S * D * 4;
constexpr size_t WS_TOKOF = WS_H2 + (size_t)S * D * 2;
constexpr size_t WS_TE = WS_TOKOF + (size_t)NE * ECAP * 4;
constexpr size_t WS_TP = WS_TE + (size_t)S * 4 * 4;
constexpr size_t WS_TG = WS_TP + (size_t)S * 4 * 4;
constexpr size_t WS_ACT = WS_TG + (size_t)S * 4 * 4;
constexpr size_t WS_YS = WS_ACT + (size_t)MAXROWS * DFF * 2;
constexpr size_t WS_END = WS_YS + (size_t)MAXROWS * D * 2;
constexpr int CW_BAR = 4096;
constexpr int CW_CNT = 8192;
constexpr int CW_ATTQ = 8448;

constexpr int RING_BYTES = 131072;
constexpr int LDSCTL_OFF = RING_BYTES;
constexpr int L_MISC = 0;
constexpr int L_CNT = 64, L_PFXU = 128, L_POFF = 192;
constexpr int LDS_BYTES = 147456;
constexpr int NWAVES = 8, NT = 512;

#define LDS_WAIT() asm volatile("s_waitcnt lgkmcnt(0)" ::: "memory")
#define VM_WAIT() asm volatile("s_waitcnt vmcnt(0)" ::: "memory")
#define RLX_AGENT __ATOMIC_RELAXED, __HIP_MEMORY_SCOPE_AGENT
typedef __bf16 bf16v2 __attribute__((ext_vector_type(2)));
__device__ __forceinline__ unsigned cvt_pk_bf16(float lo, float hi) { f32x2 v = {lo, hi}; bf16v2 r = __builtin_convertvector(v, bf16v2); return __builtin_bit_cast(unsigned, r); }
__device__ __forceinline__ float bf_lo(unsigned u) { return __builtin_bit_cast(float, u << 16); }
__device__ __forceinline__ float bf_hi(unsigned u) { return __builtin_bit_cast(float, u & 0xffff0000u); }
__device__ __forceinline__ int fresh_lane() { int l = (int)__builtin_amdgcn_mbcnt_hi(~0u, __builtin_amdgcn_mbcnt_lo(~0u, 0u)); asm volatile("" : "+v"(l)); return l; }
__device__ __forceinline__ float wave_sum(float v) {
#pragma unroll
    for (int o = 1; o < 64; o <<= 1) v += __shfl_xor(v, o);
    return v;
}
__device__ __forceinline__ float softplus_acc(float x) { return fmaxf(x, 0.f) + log1pf(expf(-fabsf(x))); }
__device__ __forceinline__ float silu_acc(float x) { return x / (1.f + expf(-x)); }

#define XB_TMO      128
#define XB_XCNT(j)  (256  + 64 * (j))
#define XB_XSUB(j)  (1280 + 64 * (j))
#define XB_XGEN(j)  (2304 + 64 * (j))
#define XB_TOP      3328
#define XB_TOPGEN   3392
#define XCD_BAR_WORDS 3456
#define XB_SPIN_CAP (1u << 18)
__device__ __forceinline__ unsigned xb_ld(unsigned* p)              { return __hip_atomic_load(p, __ATOMIC_RELAXED, __HIP_MEMORY_SCOPE_AGENT); }
__device__ __forceinline__ unsigned xb_add(unsigned* p, unsigned v) { return __hip_atomic_fetch_add(p, v, __ATOMIC_RELAXED, __HIP_MEMORY_SCOPE_AGENT); }
__device__ __forceinline__ unsigned xb_xcc_id() { return (unsigned)__builtin_amdgcn_s_getreg((3 << 11) | 20) & 0xFu; }
#define XB_SPIN(cond, bar) do { unsigned _sp = 0; while (cond) { __builtin_amdgcn_s_sleep(1); \
    if ((++_sp & 255u) == 0u) { if (xb_ld(&(bar)[XB_TMO])) break; if (_sp > XB_SPIN_CAP) { atomicAdd(&(bar)[XB_TMO], 1u); break; } } } } while (0)
struct XcdBarrier { unsigned* bar; unsigned x; volatile LAS unsigned* st; };
__device__ __forceinline__ XcdBarrier xcd_barrier_post(unsigned* bar, volatile LAS unsigned* st) {
    XcdBarrier b; b.bar = bar; b.x = xb_xcc_id(); b.st = st;
    if (threadIdx.x == 0) (void)xb_add(&bar[XB_XCNT(b.x)], 1u);
    return b;
}
__device__ __forceinline__ void xcd_barrier_complete(unsigned* bar, unsigned x, unsigned& nloc, unsigned& nx) {
    const unsigned G = gridDim.x * gridDim.y * gridDim.z;
    unsigned sum, cnt, mine, sp = 0u;
    for (;;) {
        sum = 0u; cnt = 0u; mine = 0u;
#pragma unroll
        for (unsigned j = 0; j < 16; ++j) { const unsigned c = xb_ld(&bar[XB_XCNT(j)]); sum += c; cnt += (c > 0u) ? 1u : 0u; mine = (j == x) ? c : mine; }
        if (sum == G) break;
        __builtin_amdgcn_s_sleep(1);
        if ((++sp & 255u) == 0u) { if (xb_ld(&bar[XB_TMO])) break; if (sp > XB_SPIN_CAP) { atomicAdd(&bar[XB_TMO], 1u); break; } }
    }
    nloc = mine > 0u ? mine : 1u; nx = cnt > 0u ? cnt : 1u;
}
__device__ __forceinline__ void xcd_barrier(const XcdBarrier& b) {
    asm volatile("s_waitcnt vmcnt(0)" ::: "memory");
    __syncthreads();
    if (threadIdx.x == 0) {
        unsigned* bar = b.bar;
        __builtin_amdgcn_s_waitcnt(0);
        unsigned nloc = b.st[0], nx = b.st[1];
        if (nloc == 0u) { xcd_barrier_complete(bar, b.x, nloc, nx); b.st[0] = nloc; b.st[1] = nx; }
        const unsigned old = xb_add(&bar[XB_XSUB(b.x)], 1u);
        const unsigned gen = old / nloc;
        if (old + 1u == (gen + 1u) * nloc) {
            __builtin_amdgcn_fence(__ATOMIC_RELEASE, "agent");
            asm volatile("s_waitcnt vmcnt(0)" ::: "memory");
            const unsigned og = xb_add(&bar[XB_TOP], 1u);
            const unsigned tg = og / nx;
            if (og + 1u == (tg + 1u) * nx) xb_add(&bar[XB_TOPGEN], 1u);
            else XB_SPIN(xb_ld(&bar[XB_TOPGEN]) == tg, bar);
            __builtin_amdgcn_fence(__ATOMIC_ACQUIRE, "agent");
            xb_add(&bar[XB_XGEN(b.x)], 1u);
            asm volatile("s_waitcnt vmcnt(0)" ::: "memory");
        } else {
            XB_SPIN(xb_ld(&bar[XB_XGEN(b.x)]) == gen, bar);
            __builtin_amdgcn_fence(__ATOMIC_ACQUIRE, "agent");
            asm volatile("s_waitcnt vmcnt(0)" ::: "memory");
        }
    }
    __syncthreads();
}

namespace pg8 {
constexpr int BM = 256, BK = 64, HALF = 128, HTB = HALF * BK * 2, NXCD = 8, WGM = 8, K = 2048;
template <bool FP8> struct Geo { static constexpr unsigned ROWB = FP8 ? 2048u : 4096u; static constexpr int NTK = ROWB / 128; static constexpr unsigned HSTEP = HALF * ROWB; static constexpr size_t TSTEP = 2 * (size_t)HSTEP; };
typedef int i32x4 __attribute__((ext_vector_type(4)));
typedef int i32x8 __attribute__((ext_vector_type(8)));
__host__ __device__ __forceinline__ int lds_byte(int r, int c) { const int st = (r >> 4) * 2 + (c >> 5), rr = r & 15, cc = c & 31, ob = rr * 64 + cc * 2; return st * 1024 + (ob ^ (((ob >> 9) & 1) << 5)); }
__host__ __device__ __forceinline__ void stage_rc(int b, int& R, int& C) { const int st = b / 1024, sb = b % 1024, swz = sb ^ (((sb >> 9) & 1) << 5); R = (st >> 1) * 16 + swz / 64; C = (st & 1) * 32 + (swz % 64) / 2; }
__host__ __device__ __forceinline__ int perm32(int rho) { const int n = rho >> 4, i = rho & 15; return 8 * (i >> 2) + 4 * n + (i & 3); }
struct Unit { int pm, pn, e; };

struct NatOrder {
    const char* A; const char* Bt; int nM, nN, nwg, G, c;
    __device__ void init(const void* A_, const void* Bt_, int M, int N, int G_, int c_) { A = (const char*)A_; Bt = (const char*)Bt_; nM = M / BM; nN = N / BM; nwg = nM * nN; G = G_; c = c_; }
    __device__ __forceinline__ bool next(int i, Unit& u) const {
        const long L = (long)i * G + c; if (L >= nwg) return false;
        int wgid = (int)L; { const int q = nwg / NXCD, r = nwg % NXCD, xcd = wgid % NXCD, off = wgid / NXCD; wgid = (xcd < r ? xcd * (q + 1) : r * (q + 1) + (xcd - r) * q) + off; }
        const int nig = WGM * nN, gid = wgid / nig, fm = gid * WGM, gsz = (nM - fm) < WGM ? (nM - fm) : WGM;
        u.pm = fm + ((wgid % nig) % gsz); u.pn = (wgid % nig) / gsz; u.e = 0; return true;
    }
    static constexpr bool FP8 = false;
    __device__ __forceinline__ const char* a_base(const Unit& u) const { return A + (size_t)u.pm * Geo<false>::TSTEP; }
    __device__ __forceinline__ const char* b_base(const Unit& u) const { return Bt + (size_t)u.pn * Geo<false>::TSTEP; }
    __device__ __forceinline__ void a_offs(const Unit&, const unsigned (&nat)[2], unsigned (&v)[4]) const { v[0] = nat[0]; v[1] = nat[1]; v[2] = nat[0] + Geo<false>::HSTEP; v[3] = nat[1] + Geo<false>::HSTEP; }
};
template <bool GATHER> struct MoeOrder {
    const char* A; const char* Bt; const int* tokof; const LAS int* cnt; const LAS int* pfxU; const LAS int* poff; int ntn, G, c;
    __device__ __forceinline__ bool next(int i, Unit& u) const {
        const int L = i * G + c; if (L >= __builtin_amdgcn_readfirstlane(pfxU[NE])) return false;
        int e = 0;
#pragma unroll 1
        for (; e < NE - 1; ++e) if (L < __builtin_amdgcn_readfirstlane(pfxU[e + 1])) break;
        const int r = L - __builtin_amdgcn_readfirstlane(pfxU[e]), mt = (__builtin_amdgcn_readfirstlane(cnt[e]) + 255) >> 8;
        u.e = e; u.pn = r / mt; u.pm = r - u.pn * mt; return true;
    }
    static constexpr bool FP8 = true; static constexpr unsigned ROWB = Geo<true>::ROWB;
    __device__ __forceinline__ const char* a_base(const Unit& u) const { return GATHER ? A : A + ((size_t)__builtin_amdgcn_readfirstlane(poff[u.e]) + (size_t)u.pm * BM) * ROWB; }
    __device__ __forceinline__ const char* b_base(const Unit& u) const { return Bt + ((size_t)u.e * ntn + u.pn) * Geo<true>::TSTEP; }
    __device__ __forceinline__ void a_offs(const Unit& u, const unsigned (&nat)[2], unsigned (&v)[4]) const {
        if (!GATHER) { v[0] = nat[0]; v[1] = nat[1]; v[2] = nat[0] + Geo<true>::HSTEP; v[3] = nat[1] + Geo<true>::HSTEP; return; }
        const int n = cnt[u.e];
#pragma unroll
        for (int h = 0; h < 2; ++h)
#pragma unroll
            for (int i = 0; i < 2; ++i) { const unsigned R = nat[i] / ROWB, Cb = nat[i] % ROWB; int pos = u.pm * BM + h * HALF + (int)R; pos = pos < n ? pos : n - 1;
                const int tok = tokof[u.e * ECAP + pos]; v[h * 2 + i] = (unsigned)tok * ROWB + Cb; }
    }
};

struct EpiProj {
    static constexpr bool PERM = true;
    bf16_t* P; float* DT;
    __device__ __forceinline__ void operator()(const f32x4 (&acc)[2][2][4][2], const Unit& u, int wr, int wc, int fr, int fq) const {
        const int row0 = u.pm * BM + wr * 64 + fr, col0 = u.pn * BM + wc * 32 + 8 * fq;
        if (u.pn < 22) {
#pragma unroll
            for (int ai = 0; ai < 2; ++ai)
#pragma unroll
                for (int m = 0; m < 4; ++m) { bf16_t* rowp = P + (size_t)(row0 + ai * HALF + m * 16) * NPJ + col0;
#pragma unroll
                    for (int bj = 0; bj < 2; ++bj) { const f32x4 v0 = acc[ai][bj][m][0], v1 = acc[ai][bj][m][1];
                        u32x4 w; w.x = cvt_pk_bf16(v0[0], v0[1]); w.y = cvt_pk_bf16(v0[2], v0[3]); w.z = cvt_pk_bf16(v1[0], v1[1]); w.w = cvt_pk_bf16(v1[2], v1[3]);
                        *(u32x4*)(rowp + bj * HALF) = w; } }
        } else if (wc == 0 && fq < 2) {
#pragma unroll
            for (int ai = 0; ai < 2; ++ai)
#pragma unroll
                for (int m = 0; m < 4; ++m) { float* rowp = DT + (size_t)(row0 + ai * HALF + m * 16) * H + 8 * fq;
                    *(f32x4*)(rowp) = acc[ai][0][m][0]; *(f32x4*)(rowp + 4) = acc[ai][0][m][1]; }
        }
    }
};
struct EpiRes {
    static constexpr bool PERM = false;
    const float* X; float* O;
    __device__ __forceinline__ void operator()(const f32x4 (&acc)[2][2][4][2], const Unit& u, int wr, int wc, int fr, int fq) const {
        const int row0 = u.pm * BM + wr * 64 + fr, col0 = u.pn * BM + wc * 32 + 4 * fq;
#pragma unroll
        for (int ai = 0; ai < 2; ++ai)
#pragma unroll
            for (int m = 0; m < 4; ++m) { const size_t ro = (size_t)(row0 + ai * HALF + m * 16) * D + col0;
#pragma unroll
                for (int bj = 0; bj < 2; ++bj)
#pragma unroll
                    for (int n = 0; n < 2; ++n) { const f32x4 xv = *(const f32x4*)(X + ro + bj * HALF + n * 16); *(f32x4*)(O + ro + bj * HALF + n * 16) = acc[ai][bj][m][n] + xv; } }
    }
};
constexpr float WSCALE = 64.f, WINV = 1.f / 64.f;
__device__ __forceinline__ unsigned pk4_fp8(float a, float b, float c, float d) { int p = 0; p = __builtin_amdgcn_cvt_pk_fp8_f32(a, b, p, false); p = __builtin_amdgcn_cvt_pk_fp8_f32(c, d, p, true); return (unsigned)p; }
struct EpiGU {
    static constexpr bool PERM = true;
    unsigned char* ACT; const float* bias; const LAS int* poff;
    __device__ __forceinline__ float act1(float g, float up) const { g = fminf(g, 7.f); up = fminf(fmaxf(up, -7.f), 7.f); return g * (1.f / (1.f + __expf(-1.702f * g))) * (up + 1.f); }
    __device__ __forceinline__ void operator()(const f32x4 (&acc)[2][2][4][2], const Unit& u, int wr, int wc, int fr, int fq) const {
        const int row0 = poff[u.e] + u.pm * BM + wr * 64 + fr, col0 = u.pn * BM + wc * 32 + 8 * fq;
        const float* bp = bias + (size_t)u.e * (2 * DFF) + col0;
        f32x4 bv[2][2];
#pragma unroll
        for (int bj = 0; bj < 2; ++bj)
#pragma unroll
            for (int n = 0; n < 2; ++n) bv[bj][n] = *(const f32x4*)(bp + bj * HALF + 4 * n);
#pragma unroll
        for (int ai = 0; ai < 2; ++ai)
#pragma unroll
            for (int m = 0; m < 4; ++m) { unsigned char* rowp = ACT + (size_t)(row0 + ai * HALF + m * 16) * DFF + (col0 >> 1);
#pragma unroll
                for (int bj = 0; bj < 2; ++bj) { const f32x4 v0 = acc[ai][bj][m][0] * WINV + bv[bj][0], v1 = acc[ai][bj][m][1] * WINV + bv[bj][1];
                    *(unsigned*)(rowp + bj * (HALF / 2)) = pk4_fp8(act1(v0[0], v0[1]), act1(v0[2], v0[3]), act1(v1[0], v1[1]), act1(v1[2], v1[3])); } }
    }
};
struct EpiDown {
    static constexpr bool PERM = true;
    bf16_t* YS; const float* bias; const LAS int* poff;
    __device__ __forceinline__ void operator()(const f32x4 (&acc)[2][2][4][2], const Unit& u, int wr, int wc, int fr, int fq) const {
        const int row0 = poff[u.e] + u.pm * BM + wr * 64 + fr, col0 = u.pn * BM + wc * 32 + 8 * fq;
        const float* bp = bias + (size_t)u.e * D + col0;
#pragma unroll
        for (int bj = 0; bj < 2; ++bj) { const f32x4 b0 = *(const f32x4*)(bp + bj * HALF), b1 = *(const f32x4*)(bp + bj * HALF + 4);
#pragma unroll
            for (int ai = 0; ai < 2; ++ai)
#pragma unroll
                for (int m = 0; m < 4; ++m) { bf16_t* rowp = YS + (size_t)(row0 + ai * HALF + m * 16) * D + col0 + bj * HALF;
                    const f32x4 v0 = acc[ai][bj][m][0] * WINV + b0, v1 = acc[ai][bj][m][1] * WINV + b1;
                    u32x4 w; w.x = cvt_pk_bf16(v0[0], v0[1]); w.y = cvt_pk_bf16(v0[2], v0[3]); w.z = cvt_pk_bf16(v1[0], v1[1]); w.w = cvt_pk_bf16(v1[2], v1[3]);
                    *(u32x4*)rowp = w; } }
    }
};

template <class Epi, class Sched>
__device__ __forceinline__ void gemm_phase(LAS unsigned char* lds, const Sched& S, const Epi& E) {
    const int wid = __builtin_amdgcn_readfirstlane(threadIdx.x >> 6), lane = fresh_lane(), tid = wid * 64 + lane, wr = wid >> 2, wc = wid & 3, fr = lane & 15, fq = lane >> 4;
    constexpr bool FP8 = Sched::FP8; constexpr unsigned ROWB = Geo<FP8>::ROWB, HSTEP = Geo<FP8>::HSTEP; constexpr int NTK = Geo<FP8>::NTK;
    unsigned natA[2], voffB[2];
#pragma unroll
    for (int i = 0; i < 2; ++i) { int R, C; stage_rc(tid * 16 + i * 8192, R, C); const int Rb = Epi::PERM ? ((R & ~31) + perm32(R & 31)) : R;
        natA[i] = (unsigned)R * ROWB + (unsigned)C * 2u; voffB[i] = (unsigned)Rb * ROWB + (unsigned)C * 2u; }
    const size_t kstep = (size_t)(BK * 2);
    const unsigned ldsw = (unsigned)wid * 1024u, ldsb = (unsigned)(uintptr_t)lds;
    const int aoff = lds_byte(wr * 64 + fr, fq * 8), boff = lds_byte(wc * 32 + fr, fq * 8);
#define PG8_SA(b, h) (((b) * 2 + (h)) * HTB)
#define PG8_SB(b, h) ((4 + (b) * 2 + (h)) * HTB)
#define PG8_GLDS(gbase, voff32, ldsdst) do { unsigned _keep; asm volatile("s_mov_b32 %0, m0\n\ts_mov_b32 m0, %3\n\ts_nop 0\n\tglobal_load_lds_dwordx4 %2, %1\n\ts_mov_b32 m0, %0" \
        : "=&s"(_keep) : "s"((const char*)(gbase)), "v"(voff32), "s"((unsigned)(ldsdst)) : "memory"); } while (0)
#define PG8_STAGE_A(bufoff, gbase, h) do { _Pragma("unroll") for (int _i = 0; _i < 2; ++_i) PG8_GLDS(gbase, va[(h) * 2 + _i], ldsb + (bufoff) + ldsw + _i * 8192); } while (0)
#define PG8_STAGE_B(bufoff, gbase) do { _Pragma("unroll") for (int _i = 0; _i < 2; ++_i) PG8_GLDS(gbase, voffB[_i], ldsb + (bufoff) + ldsw + _i * 8192); } while (0)
#define PG8_LDA(dst, b, h) do { _Pragma("unroll") for (int m = 0; m < 4; ++m) _Pragma("unroll") for (int k = 0; k < 2; ++k) dst[m][k] = *(const LAS i32x4*)(lds + PG8_SA(b, h) + aoff + m * 2048 + k * 1024); } while (0)
#define PG8_LDB(dst, b, h) do { _Pragma("unroll") for (int n = 0; n < 2; ++n) _Pragma("unroll") for (int k = 0; k < 2; ++k) dst[n][k] = *(const LAS i32x4*)(lds + PG8_SB(b, h) + boff + n * 2048 + k * 1024); } while (0)
#define PG8_MMA(ai, bj, At, Bt) do { __builtin_amdgcn_s_setprio(1); _Pragma("unroll") for (int m = 0; m < 4; ++m) _Pragma("unroll") for (int n = 0; n < 2; ++n) { \
        if constexpr (FP8) { acc[ai][bj][m][n] = __builtin_amdgcn_mfma_scale_f32_16x16x128_f8f6f4(__builtin_shufflevector(Bt[n][0], Bt[n][1], 0, 1, 2, 3, 4, 5, 6, 7), __builtin_shufflevector(At[m][0], At[m][1], 0, 1, 2, 3, 4, 5, 6, 7), acc[ai][bj][m][n], 0, 0, 0, 127, 0, 127); } \
        else { acc[ai][bj][m][n] = __builtin_amdgcn_mfma_f32_16x16x32_bf16(__builtin_bit_cast(bf16x8, Bt[n][0]), __builtin_bit_cast(bf16x8, At[m][0]), acc[ai][bj][m][n], 0, 0, 0); \
               acc[ai][bj][m][n] = __builtin_amdgcn_mfma_f32_16x16x32_bf16(__builtin_bit_cast(bf16x8, Bt[n][1]), __builtin_bit_cast(bf16x8, At[m][1]), acc[ai][bj][m][n], 0, 0, 0); } } \
        __builtin_amdgcn_s_setprio(0); } while (0)
#define PG8_WAIT_V(n) asm volatile("s_waitcnt vmcnt(" #n ")" ::: "memory")
#define PG8_WAIT_L(n) asm volatile("s_waitcnt lgkmcnt(" #n ")" ::: "memory")
#define PG8_BAR __builtin_amdgcn_s_barrier()
#define PG8_SCHED __builtin_amdgcn_sched_barrier(0)
    Unit cur, nxt; int ui = 0;
    if (!S.next(0, cur)) return;
    f32x4 acc[2][2][4][2];
#pragma unroll
    for (int a = 0; a < 2; ++a)
#pragma unroll
        for (int b = 0; b < 2; ++b)
#pragma unroll
            for (int m = 0; m < 4; ++m)
#pragma unroll
                for (int n = 0; n < 2; ++n) acc[a][b][m][n] = (f32x4){0.f, 0.f, 0.f, 0.f};
    i32x4 At[4][2], B0[2][2], B1[2][2];
    unsigned va[4]; S.a_offs(cur, natA, va);
    const char* cA = S.a_base(cur); const char* cB = S.b_base(cur);
    PG8_STAGE_B(PG8_SB(0, 0), cB); PG8_STAGE_B(PG8_SB(0, 1), cB + HSTEP); PG8_STAGE_A(PG8_SA(0, 0), cA, 0); PG8_STAGE_A(PG8_SA(0, 1), cA, 1);
    if (wr == 1) PG8_BAR;
    PG8_WAIT_V(2); PG8_BAR;
    PG8_STAGE_B(PG8_SB(1, 0), cB + kstep); PG8_STAGE_A(PG8_SA(1, 0), cA + kstep, 0); PG8_STAGE_B(PG8_SB(1, 1), cB + HSTEP + kstep);
    PG8_WAIT_V(6); PG8_BAR;
    for (;;) {
        const bool has_next = S.next(ui + 1, nxt);
        const char* nA = has_next ? S.a_base(nxt) : cA; const char* nB = has_next ? S.b_base(nxt) : cB;
        for (int t = 0; t < NTK; t += 2) {
            const bool last = (t == NTK - 2);
            const char* a1 = cA + (size_t)(t + 1) * kstep;
            const char* a2 = last ? nA : cA + (size_t)(t + 2) * kstep; const char* b2 = last ? nB : cB + (size_t)(t + 2) * kstep;
            const char* a3 = a2 + kstep; const char* b3 = b2 + kstep;
            PG8_LDB(B0, 0, 0); PG8_LDB(B1, 0, 1); PG8_SCHED; PG8_LDA(At, 0, 0); PG8_STAGE_A(PG8_SA(1, 1), a1, 1);
            PG8_WAIT_V(8); PG8_WAIT_L(0); PG8_BAR; PG8_MMA(0, 0, At, B0); PG8_MMA(0, 1, At, B1); PG8_BAR; PG8_SCHED;
            if (last && has_next) S.a_offs(nxt, natA, va);
            PG8_LDA(At, 0, 1); PG8_STAGE_B(PG8_SB(0, 0), b2); PG8_STAGE_B(PG8_SB(0, 1), b2 + HSTEP); PG8_STAGE_A(PG8_SA(0, 0), a2, 0);
            PG8_WAIT_V(8); PG8_WAIT_L(0); PG8_BAR; PG8_MMA(1, 0, At, B0); PG8_MMA(1, 1, At, B1); PG8_BAR; PG8_SCHED;
            PG8_LDB(B0, 1, 0); PG8_LDB(B1, 1, 1); PG8_SCHED; PG8_LDA(At, 1, 0); PG8_STAGE_A(PG8_SA(0, 1), a2, 1);
            PG8_WAIT_V(8); PG8_WAIT_L(0); PG8_BAR; PG8_MMA(0, 0, At, B0); PG8_MMA(0, 1, At, B1); PG8_BAR; PG8_SCHED;
            PG8_LDA(At, 1, 1); PG8_STAGE_B(PG8_SB(1, 0), b3); PG8_STAGE_B(PG8_SB(1, 1), b3 + HSTEP); PG8_STAGE_A(PG8_SA(1, 0), a3, 0);
            PG8_WAIT_V(8); PG8_WAIT_L(0); PG8_BAR; PG8_MMA(1, 0, At, B0); PG8_MMA(1, 1, At, B1); PG8_BAR; PG8_SCHED;
        }
        if (wr == 0) PG8_BAR;
        { const int l2 = fresh_lane(); E(acc, cur, wr, wc, l2 & 15, l2 >> 4); }
        if (!has_next) break;
#pragma unroll
        for (int a = 0; a < 2; ++a)
#pragma unroll
            for (int b = 0; b < 2; ++b)
#pragma unroll
                for (int m = 0; m < 4; ++m)
#pragma unroll
                    for (int n = 0; n < 2; ++n) acc[a][b][m][n] = (f32x4){0.f, 0.f, 0.f, 0.f};
        cur = nxt; cA = nA; cB = nB; ++ui;
        if (wr == 1) PG8_BAR;
    }
    PG8_WAIT_V(0);
    PG8_BAR;
#undef PG8_SA
#undef PG8_SB
#undef PG8_STAGE_A
#undef PG8_GLDS
#undef PG8_STAGE_B
#undef PG8_LDA
#undef PG8_LDB
#undef PG8_MMA
#undef PG8_WAIT_V
#undef PG8_WAIT_L
#undef PG8_BAR
#undef PG8_SCHED
}
}

struct Args { const float* in[18]; float* out; unsigned char* ws; int ph_lo, ph_hi; };
struct Frame { LAS unsigned char* lds; int tid, lane, wave, vcu, G; };

__device__ __forceinline__ void transpose_item(const float* W, int ldw, int nvalid, bf16_t* WT, LAS float* scr, int kb, int nb, int lane) {
    const int k0 = 64 * kb, n0 = 32 * nb, nn = n0 + (lane & 31); const bool ok = nn < nvalid;
    const float* src = W + (size_t)(k0 + (lane >> 5)) * ldw + (ok ? nn : 0);
    float v[32];
#pragma unroll
    for (int i = 0; i < 32; ++i) v[i] = src[(size_t)(2 * i) * ldw];
#pragma unroll
    for (int i = 0; i < 32; ++i) scr[(2 * i + (lane >> 5)) * 33 + (lane & 31)] = ok ? v[i] : 0.f;
    LDS_WAIT(); asm volatile("" ::: "memory");
    const int c = lane & 7;
#pragma unroll
    for (int j = 0; j < 4; ++j) { const int n = (lane >> 3) + 8 * j; const LAS float* s = scr + (8 * c) * 33 + n;
        u32x4 o; o.x = cvt_pk_bf16(s[0 * 33], s[1 * 33]); o.y = cvt_pk_bf16(s[2 * 33], s[3 * 33]); o.z = cvt_pk_bf16(s[4 * 33], s[5 * 33]); o.w = cvt_pk_bf16(s[6 * 33], s[7 * 33]);
        *(u32x4*)(WT + (size_t)(n0 + n) * 2048 + k0 + 8 * c) = o; }
    LDS_WAIT(); asm volatile("" ::: "memory");
}
__device__ __forceinline__ void transpose_item_fp8(const float* W, int ldw, unsigned char* WT, LAS float* scr, int kb, int nb, int lane) {
    const int k0 = 64 * kb, n0 = 32 * nb;
    const float* src = W + (size_t)(k0 + (lane >> 5)) * ldw + n0 + (lane & 31);
    float v[32];
#pragma unroll
    for (int i = 0; i < 32; ++i) v[i] = src[(size_t)(2 * i) * ldw];
#pragma unroll
    for (int i = 0; i < 32; ++i) scr[(2 * i + (lane >> 5)) * 33 + (lane & 31)] = v[i] * pg8::WSCALE;
    LDS_WAIT(); asm volatile("" ::: "memory");
    const int c = lane & 3;
#pragma unroll
    for (int j = 0; j < 2; ++j) { const int n = (lane >> 2) + 16 * j; const LAS float* sp = scr + (16 * c) * 33 + n;
        u32x4 o; o.x = pg8::pk4_fp8(sp[0 * 33], sp[1 * 33], sp[2 * 33], sp[3 * 33]); o.y = pg8::pk4_fp8(sp[4 * 33], sp[5 * 33], sp[6 * 33], sp[7 * 33]);
        o.z = pg8::pk4_fp8(sp[8 * 33], sp[9 * 33], sp[10 * 33], sp[11 * 33]); o.w = pg8::pk4_fp8(sp[12 * 33], sp[13 * 33], sp[14 * 33], sp[15 * 33]);
        *(u32x4*)(WT + (size_t)(n0 + n) * 2048 + k0 + 16 * c) = o; }
    LDS_WAIT(); asm volatile("" ::: "memory");
}
__device__ __forceinline__ float rms_load(const float* xrow, int lane, f32x4 (&v)[8]) {
    const f32x4* xr = (const f32x4*)xrow + lane; float s = 0.f;
#pragma unroll
    for (int j = 0; j < 8; ++j) { v[j] = xr[64 * j]; s += (v[j].x * v[j].x + v[j].y * v[j].y) + (v[j].z * v[j].z + v[j].w * v[j].w); }
    return rsqrtf(wave_sum(s) * (1.f / D) + EPS);
}

__device__ __forceinline__ void p0_prologue(const Frame& F, const Args& a) {
    LAS float* scr = (LAS float*)(F.lds + F.wave * 16384);
    const int gw = F.vcu * NWAVES + F.wave, NGW = F.G * NWAVES;
    const float* x = a.in[0]; const float* g_mix = a.in[1]; const float* w_in = a.in[2]; const float* w_out = a.in[9]; const float* w_gu = a.in[13]; const float* w_dn = a.in[15];
    bf16_t* WinT = (bf16_t*)(a.ws + WS_WIN); bf16_t* WoutT = (bf16_t*)(a.ws + WS_WOUT); unsigned char* WguT = (unsigned char*)(a.ws + WS_WGU); unsigned char* WdnT = (unsigned char*)(a.ws + WS_WDN); bf16_t* XN = (bf16_t*)(a.ws + WS_XN);
    for (int m = gw; m < S; m += NGW) { f32x4 v[8]; const float r = rms_load(x + (size_t)m * D, F.lane, v);
        const f32x4* gp = (const f32x4*)g_mix + F.lane; u32x2* o8 = (u32x2*)(XN + (size_t)m * D) + F.lane;
#pragma unroll
        for (int j = 0; j < 8; ++j) { const f32x4 g = gp[64 * j]; u32x2 w; w.x = cvt_pk_bf16(v[j].x * r * g.x, v[j].y * r * g.y); w.y = cvt_pk_bf16(v[j].z * r * g.z, v[j].w * r * g.w); o8[64 * j] = w; } }
    constexpr int I_IN = 32 * (NPAD / 32), I_OUT = 32 * (D / 32), I_GU = 32 * (2 * DFF / 32), I_DN = 32 * (D / 32);
    constexpr int NITEMS = I_IN + I_OUT + NE * I_GU + NE * I_DN;
    for (int it = gw; it < NITEMS; it += NGW) {
        int r = it;
        if (r < I_IN) { transpose_item(w_in, NPROJ, NPROJ, WinT, scr, r / (NPAD / 32), r % (NPAD / 32), F.lane); continue; } r -= I_IN;
        if (r < I_OUT) { transpose_item(w_out, D, D, WoutT, scr, r / (D / 32), r % (D / 32), F.lane); continue; } r -= I_OUT;
        if (r < NE * I_GU) { const int e = r / I_GU, q = r % I_GU; transpose_item_fp8(w_gu + (size_t)e * D * 2 * DFF, 2 * DFF, WguT + (size_t)e * 2 * DFF * D, scr, q / (2 * DFF / 32), q % (2 * DFF / 32), F.lane); continue; } r -= NE * I_GU;
        { const int e = r / I_DN, q = r % I_DN; transpose_item_fp8(w_dn + (size_t)e * DFF * D, D, WdnT + (size_t)e * D * DFF, scr, q / (D / 32), q % (D / 32), F.lane); }
    }
}

constexpr int XS_STRIDE = 1024 + 16, BS_STRIDE = 256 + 16;
constexpr int L_XS = 0, L_BS = 64 * XS_STRIDE, L_CS = L_BS + 64 * BS_STRIDE, L_WV = L_CS + 64 * BS_STRIDE;
static_assert(L_WV + 8 * 768 <= RING_BYTES, "ssd lds");
__device__ __forceinline__ void tr_read2(unsigned a0, unsigned a1, u32x2& r0, u32x2& r1) {
    asm volatile("ds_read_b64_tr_b16 %0, %2\n\tds_read_b64_tr_b16 %1, %3\n\ts_waitcnt lgkmcnt(0)" : "=&v"(r0), "=&v"(r1) : "v"(a0), "v"(a1) : "memory");
}
__device__ __forceinline__ void tr_read8(unsigned a0, unsigned a1, u32x2 (&r)[8]) {
    asm volatile("ds_read_b64_tr_b16 %0, %8\n\tds_read_b64_tr_b16 %1, %9\n\tds_read_b64_tr_b16 %2, %8 offset:32\n\tds_read_b64_tr_b16 %3, %9 offset:32\n\t"
                 "ds_read_b64_tr_b16 %4, %8 offset:64\n\tds_read_b64_tr_b16 %5, %9 offset:64\n\tds_read_b64_tr_b16 %6, %8 offset:96\n\tds_read_b64_tr_b16 %7, %9 offset:96\n\ts_waitcnt lgkmcnt(0)"
                 : "=&v"(r[0]), "=&v"(r[1]), "=&v"(r[2]), "=&v"(r[3]), "=&v"(r[4]), "=&v"(r[5]), "=&v"(r[6]), "=&v"(r[7]) : "v"(a0), "v"(a1) : "memory");
}
__device__ __forceinline__ bf16x8 mk_frag(u32x2 lo, u32x2 hi) { u32x4 v; v.x = lo.x; v.y = lo.y; v.z = hi.x; v.w = hi.y; return __builtin_bit_cast(bf16x8, v); }
__device__ __forceinline__ float silu_fast(float x) { return x * __builtin_amdgcn_rcpf(1.f + __expf(-x)); }

__device__ __forceinline__ void ssd_a_unit(const Frame& F, const Args& a, int c, int g) {
    const bf16_t* PROJ = (const bf16_t*)(a.ws + WS_PROJ); const float* DT = (const float*)(a.ws + WS_DT);
    float* ACUM = (float*)(a.ws + WS_ACUM); float* DEC = (float*)(a.ws + WS_DEC); bf16_t* CC = (bf16_t*)(a.ws + WS_CC); float* Y0 = (float*)(a.ws + WS_Y0); bf16_t* SC = (bf16_t*)(a.ws + WS_SC);
    const float* cw = a.in[3]; const float* cb = a.in[4];
    int tid = F.tid; asm volatile("" : "+v"(tid));
    const int t0 = c * CL, lane = tid & 63, w = F.wave, h = g * 8 + w;
    LAS unsigned char* lds = F.lds;
    if (tid < 384) {
        const int cg = tid % 96, tr = tid / 96;
        int ch, dstride; LAS unsigned char* dst;
        if (cg < 64) { ch = g * 512 + cg * 8; dst = lds + L_XS + cg * 16; dstride = XS_STRIDE; }
        else if (cg < 80) { ch = 1024 + g * 128 + (cg - 64) * 8; dst = lds + L_BS + (cg - 64) * 16; dstride = BS_STRIDE; }
        else { ch = 1280 + g * 128 + (cg - 80) * 8; dst = lds + L_CS + (cg - 80) * 16; dstride = BS_STRIDE; }
        float wt[4][8], bs[8];
#pragma unroll
        for (int k = 0; k < 4; ++k) { const f32x4 w0 = *(const f32x4*)(cw + k * XBC + ch), w1 = *(const f32x4*)(cw + k * XBC + ch + 4);
            wt[k][0] = w0.x; wt[k][1] = w0.y; wt[k][2] = w0.z; wt[k][3] = w0.w; wt[k][4] = w1.x; wt[k][5] = w1.y; wt[k][6] = w1.z; wt[k][7] = w1.w; }
        { const f32x4 b0 = *(const f32x4*)(cb + ch), b1 = *(const f32x4*)(cb + ch + 4); bs[0] = b0.x; bs[1] = b0.y; bs[2] = b0.z; bs[3] = b0.w; bs[4] = b1.x; bs[5] = b1.y; bs[6] = b1.z; bs[7] = b1.w; }
        const int tb = t0 + tr * 16;
        u32x4 rows[19];
#pragma unroll
        for (int i = 0; i < 19; ++i) { const int tt = tb - 3 + i; rows[i] = (u32x4){0u, 0u, 0u, 0u}; if (tt >= 0) rows[i] = *(const u32x4*)(PROJ + (size_t)tt * NPJ + C_XBC + ch); }
#pragma unroll
        for (int i = 0; i < 16; ++i) {
            float acc[8];
#pragma unroll
            for (int j = 0; j < 8; ++j) acc[j] = bs[j];
#pragma unroll
            for (int k = 0; k < 4; ++k) { const u32x4 xv = rows[i + k];
                acc[0] = fmaf(wt[k][0], bf_lo(xv.x), acc[0]); acc[1] = fmaf(wt[k][1], bf_hi(xv.x), acc[1]); acc[2] = fmaf(wt[k][2], bf_lo(xv.y), acc[2]); acc[3] = fmaf(wt[k][3], bf_hi(xv.y), acc[3]);
                acc[4] = fmaf(wt[k][4], bf_lo(xv.z), acc[4]); acc[5] = fmaf(wt[k][5], bf_hi(xv.z), acc[5]); acc[6] = fmaf(wt[k][6], bf_lo(xv.w), acc[6]); acc[7] = fmaf(wt[k][7], bf_hi(xv.w), acc[7]); }
            u32x4 o; o.x = cvt_pk_bf16(silu_fast(acc[0]), silu_fast(acc[1])); o.y = cvt_pk_bf16(silu_fast(acc[2]), silu_fast(acc[3])); o.z = cvt_pk_bf16(silu_fast(acc[4]), silu_fast(acc[5])); o.w = cvt_pk_bf16(silu_fast(acc[6]), silu_fast(acc[7]));
            *(LAS u32x4*)(dst + (tr * 16 + i) * dstride) = o;
            if (cg >= 80) *(u32x4*)(CC + (size_t)(tb + i) * 256 + g * 128 + (cg - 80) * 8) = o;
        }
    }
    __syncthreads();
    const int fr = lane & 15, fq = lane >> 4;
    LAS float* wv = (LAS float*)(lds + L_WV + w * 768);
    const float Ah = -expf(a.in[6][h]), Dh = a.in[7][h];
    {
        const float dtv = softplus_acc(DT[(size_t)(t0 + lane) * H + h] + a.in[5][h]);
        float ac = dtv * Ah;
#pragma unroll
        for (int o = 1; o < 64; o <<= 1) { const float n = __shfl_up(ac, o); if (lane >= o) ac += n; }
        const float atot = __shfl(ac, 63);
        wv[lane] = ac; wv[64 + lane] = dtv; wv[128 + lane] = dtv * __expf(atot - ac);
        ACUM[(size_t)(t0 + lane) * H + h] = ac; if (lane == 0) DEC[c * H + h] = __expf(atot);
    }
    LDS_WAIT();
    const unsigned lbase = (unsigned)(uintptr_t)lds;
    f32x4 cbt[4][4];
#pragma unroll
    for (int i = 0; i < 4; ++i)
#pragma unroll
        for (int j = 0; j < 4; ++j) cbt[i][j] = (f32x4){0.f, 0.f, 0.f, 0.f};
#pragma unroll
    for (int kk = 0; kk < 4; ++kk) { bf16x8 af[4], bfr[4];
#pragma unroll
        for (int i = 0; i < 4; ++i) { af[i] = *(const LAS bf16x8*)(lds + L_BS + (16 * i + fr) * BS_STRIDE + (32 * kk + 8 * fq) * 2); bfr[i] = *(const LAS bf16x8*)(lds + L_CS + (16 * i + fr) * BS_STRIDE + (32 * kk + 8 * fq) * 2); }
#pragma unroll
        for (int i = 0; i < 4; ++i)
#pragma unroll
            for (int j = 0; j < 4; ++j) cbt[i][j] = __builtin_amdgcn_mfma_f32_16x16x32_bf16(af[i], bfr[j], cbt[i][j], 0, 0, 0); }
    bf16x8 mt[4][2];
    {
        float acl[4];
#pragma unroll
        for (int j = 0; j < 4; ++j) acl[j] = wv[16 * j + fr];
#pragma unroll
        for (int u = 0; u < 2; ++u) {
            const f32x4 as0 = *(const LAS f32x4*)(wv + 32 * u + 4 * fq), as1 = *(const LAS f32x4*)(wv + 32 * u + 16 + 4 * fq);
            const f32x4 ds0 = *(const LAS f32x4*)(wv + 64 + 32 * u + 4 * fq), ds1 = *(const LAS f32x4*)(wv + 64 + 32 * u + 16 + 4 * fq);
#pragma unroll
            for (int j = 0; j < 4; ++j) { const int l = 16 * j + fr; float m0[4], m1[4];
#pragma unroll
                for (int r = 0; r < 4; ++r) { const int s0 = 32 * u + 4 * fq + r, s1 = s0 + 16;
                    m0[r] = (s0 <= l) ? cbt[2 * u][j][r] * __expf(acl[j] - as0[r]) * ds0[r] : 0.f;
                    m1[r] = (s1 <= l) ? cbt[2 * u + 1][j][r] * __expf(acl[j] - as1[r]) * ds1[r] : 0.f; }
                u32x4 pk; pk.x = cvt_pk_bf16(m0[0], m0[1]); pk.y = cvt_pk_bf16(m0[2], m0[3]); pk.z = cvt_pk_bf16(m1[0], m1[1]); pk.w = cvt_pk_bf16(m1[2], m1[3]);
                mt[j][u] = __builtin_bit_cast(bf16x8, pk); }
        }
    }
    {
        f32x4 yd[4][4];
#pragma unroll
        for (int i = 0; i < 4; ++i)
#pragma unroll
            for (int j = 0; j < 4; ++j) yd[i][j] = (f32x4){0.f, 0.f, 0.f, 0.f};
        const unsigned xa = lbase + L_XS + ((lane & 15) >> 2) * XS_STRIDE + (w * 64 + 4 * (lane & 3)) * 2;
#pragma unroll
        for (int u = 0; u < 2; ++u)
#pragma unroll
            for (int i = 0; i < 4; ++i) { u32x2 r0, r1; const unsigned ad = xa + (32 * u + 4 * fq) * XS_STRIDE + 32 * i; tr_read2(ad, ad + 16 * XS_STRIDE, r0, r1); const bf16x8 xf = mk_frag(r0, r1);
#pragma unroll
                for (int j = 0; j < 4; ++j) yd[i][j] = __builtin_amdgcn_mfma_f32_16x16x32_bf16(xf, mt[j][u], yd[i][j], 0, 0, 0); }
        float* yo = Y0 + ((size_t)(c * H + h) * 16) * 256 + lane * 4;
#pragma unroll
        for (int i = 0; i < 4; ++i)
#pragma unroll
            for (int j = 0; j < 4; ++j) { const u32x2 xv = *(const LAS u32x2*)(lds + L_XS + (16 * j + fr) * XS_STRIDE + (w * 64 + 16 * i + 4 * fq) * 2);
                f32x4 o = yd[i][j]; o.x = fmaf(Dh, bf_lo(xv.x), o.x); o.y = fmaf(Dh, bf_hi(xv.x), o.y); o.z = fmaf(Dh, bf_lo(xv.y), o.z); o.w = fmaf(Dh, bf_hi(xv.y), o.w);
                *(f32x4*)(yo + (i * 4 + j) * 256) = o; }
    }
    {
        bf16x8 xw[4][2];
        const unsigned xa = lbase + L_XS + ((lane & 15) >> 2) * XS_STRIDE + (w * 64 + 4 * (lane & 3)) * 2;
#pragma unroll
        for (int ks = 0; ks < 2; ++ks) {
            const f32x4 w0 = *(const LAS f32x4*)(wv + 128 + 32 * ks + 8 * fq), w1 = *(const LAS f32x4*)(wv + 128 + 32 * ks + 8 * fq + 4);
#pragma unroll
            for (int i = 0; i < 4; ++i) { u32x2 r0, r1; const unsigned ad = xa + (32 * ks + 8 * fq) * XS_STRIDE + 32 * i; tr_read2(ad, ad + 4 * XS_STRIDE, r0, r1);
                u32x4 pk; pk.x = cvt_pk_bf16(bf_lo(r0.x) * w0.x, bf_hi(r0.x) * w0.y); pk.y = cvt_pk_bf16(bf_lo(r0.y) * w0.z, bf_hi(r0.y) * w0.w);
                pk.z = cvt_pk_bf16(bf_lo(r1.x) * w1.x, bf_hi(r1.x) * w1.y); pk.w = cvt_pk_bf16(bf_lo(r1.y) * w1.z, bf_hi(r1.y) * w1.w);
                xw[i][ks] = __builtin_bit_cast(bf16x8, pk); }
        }
        const unsigned ba = lbase + L_BS + ((lane & 15) >> 2) * BS_STRIDE + (4 * (lane & 3)) * 2;
        u32x2* so = (u32x2*)(SC + ((size_t)(c * H + h) * 32) * 256) + lane;
#pragma unroll
        for (int nt = 0; nt < 8; ++nt) {
            f32x4 sc[4];
#pragma unroll
            for (int i = 0; i < 4; ++i) sc[i] = (f32x4){0.f, 0.f, 0.f, 0.f};
#pragma unroll
            for (int ks = 0; ks < 2; ++ks) { u32x2 r0, r1; const unsigned ad = ba + (32 * ks + 8 * fq) * BS_STRIDE + 32 * nt; tr_read2(ad, ad + 4 * BS_STRIDE, r0, r1); const bf16x8 bt = mk_frag(r0, r1);
#pragma unroll
                for (int i = 0; i < 4; ++i) sc[i] = __builtin_amdgcn_mfma_f32_16x16x32_bf16(bt, xw[i][ks], sc[i], 0, 0, 0); }
#pragma unroll
            for (int i = 0; i < 4; ++i) { u32x2 o; o.x = cvt_pk_bf16(sc[i].x, sc[i].y); o.y = cvt_pk_bf16(sc[i].z, sc[i].w); so[(nt * 4 + i) * 64] = o; }
        }
    }
    __syncthreads();
}

__device__ __forceinline__ void ssd_scan(const Frame& F, const Args& a) {
    if (F.tid >= 256) return;
    const unsigned* SC = (const unsigned*)(a.ws + WS_SC); unsigned* PV = (unsigned*)(a.ws + WS_PREV); const float* DEC = (const float*)(a.ws + WS_DEC);
    const int i = F.vcu * 256 + F.tid;
    if (i >= 65536) return;
    const int h = i >> 12;
    float c0 = 0.f, c1 = 0.f;
    for (int cb = 0; cb < NCH; cb += 16) {
        unsigned sv[16]; float dv[16];
#pragma unroll
        for (int k = 0; k < 16; ++k) { sv[k] = SC[(size_t)(cb + k) * 65536 + i]; dv[k] = DEC[(cb + k) * H + h]; }
#pragma unroll
        for (int k = 0; k < 16; ++k) { PV[(size_t)(cb + k) * 65536 + i] = cvt_pk_bf16(c0, c1); c0 = fmaf(c0, dv[k], bf_lo(sv[k])); c1 = fmaf(c1, dv[k], bf_hi(sv[k])); }
    }
}

__device__ __forceinline__ void ssd_c_unit(const Frame& F, const Args& a, int c, int g) {
    const bf16_t* PROJ = (const bf16_t*)(a.ws + WS_PROJ); const float* ACUM = (const float*)(a.ws + WS_ACUM); const bf16_t* CC = (const bf16_t*)(a.ws + WS_CC);
    const float* Y0 = (const float*)(a.ws + WS_Y0); const bf16_t* PV = (const bf16_t*)(a.ws + WS_PREV); bf16_t* MIX = (bf16_t*)(a.ws + WS_MIX); const float* g_ssm = a.in[8];
    const int t0 = c * CL, lane = F.lane, w = F.wave, h = g * 8 + w, fr = lane & 15, fq = lane >> 4;
    LAS float* red = (LAS float*)(F.lds);
    f32x4 yo[4][4];
#pragma unroll
    for (int i = 0; i < 4; ++i)
#pragma unroll
        for (int j = 0; j < 4; ++j) yo[i][j] = (f32x4){0.f, 0.f, 0.f, 0.f};
    const u32x2* pv = (const u32x2*)(PV + ((size_t)(c * H + h) * 32) * 256) + lane;
#pragma unroll
    for (int u = 0; u < 4; ++u) { bf16x8 pf[4], cf[4];
#pragma unroll
        for (int i = 0; i < 4; ++i) pf[i] = mk_frag(pv[((2 * u) * 4 + i) * 64], pv[((2 * u + 1) * 4 + i) * 64]);
#pragma unroll
        for (int j = 0; j < 4; ++j) { const bf16_t* cp = CC + (size_t)(t0 + 16 * j + fr) * 256 + g * 128 + 32 * u + 4 * fq; cf[j] = mk_frag(*(const u32x2*)cp, *(const u32x2*)(cp + 16)); }
#pragma unroll
        for (int i = 0; i < 4; ++i)
#pragma unroll
            for (int j = 0; j < 4; ++j) yo[i][j] = __builtin_amdgcn_mfma_f32_16x16x32_bf16(pf[i], cf[j], yo[i][j], 0, 0, 0); }
    const float* y0 = Y0 + ((size_t)(c * H + h) * 16) * 256 + lane * 4;
    float ssq[4];
#pragma unroll
    for (int j = 0; j < 4; ++j) { const int t = t0 + 16 * j + fr; const float ea = __expf(ACUM[(size_t)t * H + h]); float sq = 0.f;
#pragma unroll
        for (int i = 0; i < 4; ++i) { const f32x4 b = *(const f32x4*)(y0 + (i * 4 + j) * 256); const u32x2 zv = *(const u32x2*)(PROJ + (size_t)t * NPJ + C_Z + h * HD + 16 * i + 4 * fq);
            f32x4 y; y.x = fmaf(ea, yo[i][j].x, b.x) * silu_fast(bf_lo(zv.x)); y.y = fmaf(ea, yo[i][j].y, b.y) * silu_fast(bf_hi(zv.x)); y.z = fmaf(ea, yo[i][j].z, b.z) * silu_fast(bf_lo(zv.y)); y.w = fmaf(ea, yo[i][j].w, b.w) * silu_fast(bf_hi(zv.y));
            yo[i][j] = y; sq += (y.x * y.x + y.y * y.y) + (y.z * y.z + y.w * y.w); }
        sq += __shfl_xor(sq, 16); sq += __shfl_xor(sq, 32); ssq[j] = sq; }
    if (fq == 0) {
#pragma unroll
        for (int j = 0; j < 4; ++j) red[(16 * j + fr) * 8 + w] = ssq[j]; }
    __syncthreads();
#pragma unroll
    for (int j = 0; j < 4; ++j) { const f32x4 r0 = *(const LAS f32x4*)(red + (16 * j + fr) * 8), r1 = *(const LAS f32x4*)(red + (16 * j + fr) * 8 + 4);
        const float tot = ((r0.x + r0.y) + (r0.z + r0.w)) + ((r1.x + r1.y) + (r1.z + r1.w)); const float rs = rsqrtf(tot * (1.f / 512.f) + EPS);
        const int t = t0 + 16 * j + fr;
#pragma unroll
        for (int i = 0; i < 4; ++i) { const int col = h * HD + 16 * i + 4 * fq; const f32x4 gs = *(const f32x4*)(g_ssm + col); const f32x4 y = yo[i][j];
            u32x2 o; o.x = cvt_pk_bf16(y.x * rs * gs.x, y.y * rs * gs.y); o.y = cvt_pk_bf16(y.z * rs * gs.z, y.w * rs * gs.w);
            *(u32x2*)(MIX + (size_t)t * D + 1024 + col) = o; } }
    __syncthreads();
}

constexpr int VT_STRIDE = 144, VT_BYTES = 64 * VT_STRIDE;
__device__ __forceinline__ void attn_unit(const Frame& F, const Args& a, int h, int t0) {
    const bf16_t* PROJ = (const bf16_t*)(a.ws + WS_PROJ); bf16_t* MIX = (bf16_t*)(a.ws + WS_MIX);
    const int lane = fresh_lane(), fr = lane & 15, fq = lane >> 4;
    LAS unsigned char* vt = F.lds + F.wave * VT_BYTES;
    const unsigned vrd = (unsigned)(uintptr_t)vt + ((lane & 15) >> 2) * VT_STRIDE + 4 * (lane & 3) * 2 + 4 * fq * VT_STRIDE;
    bf16x8 qf[2][2];
#pragma unroll
    for (int qt = 0; qt < 2; ++qt)
#pragma unroll
        for (int kk = 0; kk < 2; ++kk) qf[qt][kk] = *(const bf16x8*)(PROJ + (size_t)(t0 + 16 * qt + fr) * NPJ + h * HD + 32 * kk + 8 * fq);
    bf16x8 Ua, Ub, Uones;
    { u32x4 ua, ub;
      unsigned e[8], g[8];
#pragma unroll
      for (int j = 0; j < 8; ++j) { const int sp = (j < 4) ? (4 * fq + j) : (16 + 4 * fq + (j - 4)); e[j] = (sp >= fr) ? 0x3F80u : 0u; g[j] = (sp >= 16 + fr) ? 0x3F80u : 0u; }
      ua.x = e[0] | (e[1] << 16); ua.y = e[2] | (e[3] << 16); ua.z = e[4] | (e[5] << 16); ua.w = e[6] | (e[7] << 16);
      ub.x = g[0] | (g[1] << 16); ub.y = g[2] | (g[3] << 16); ub.z = g[4] | (g[5] << 16); ub.w = g[6] | (g[7] << 16);
      Ua = __builtin_bit_cast(bf16x8, ua); Ub = __builtin_bit_cast(bf16x8, ub); const u32x4 on = {0x3F803F80u, 0x3F803F80u, 0x3F803F80u, 0x3F803F80u}; Uones = __builtin_bit_cast(bf16x8, on); }
    f32x4 o[4][2];
#pragma unroll
    for (int i = 0; i < 4; ++i)
#pragma unroll
        for (int j = 0; j < 2; ++j) o[i][j] = (f32x4){0.f, 0.f, 0.f, 0.f};
    float carry[2] = {0.f, 0.f};
    const f32x4 z4 = {0.f, 0.f, 0.f, 0.f};
    const int sd = t0 & ~63;
    for (int s0 = sd; s0 >= 0; s0 -= 64) {
        bf16x8 kf[4][2];
#pragma unroll
        for (int st = 0; st < 4; ++st)
#pragma unroll
            for (int kk = 0; kk < 2; ++kk) kf[st][kk] = *(const bf16x8*)(PROJ + (size_t)(s0 + 16 * st + fr) * NPJ + C_K + h * HD + 32 * kk + 8 * fq);
        { u32x4 vv[8];
#pragma unroll
          for (int i = 0; i < 8; ++i) vv[i] = *(const u32x4*)(PROJ + (size_t)(s0 + (lane >> 3) + 8 * i) * NPJ + C_V + h * HD + (lane & 7) * 8);
#pragma unroll
          for (int i = 0; i < 8; ++i) *(LAS u32x4*)(vt + ((lane >> 3) + 8 * i) * VT_STRIDE + (lane & 7) * 16) = vv[i]; }
        LDS_WAIT();
        const bool diag = (s0 == sd);
#pragma unroll
        for (int qt = 0; qt < 2; ++qt) {
            const int lim = diag ? (t0 - sd + 16 * qt + fr) : 4096;
            f32x4 sx[4];
#pragma unroll
            for (int st = 0; st < 4; ++st) { sx[st] = __builtin_amdgcn_mfma_f32_16x16x32_bf16(kf[st][0], qf[qt][0], z4, 0, 0, 0); sx[st] = __builtin_amdgcn_mfma_f32_16x16x32_bf16(kf[st][1], qf[qt][1], sx[st], 0, 0, 0); }
            float lk[4][4]; float tot = 0.f;
#pragma unroll
            for (int st = 0; st < 4; ++st)
#pragma unroll
                for (int r = 0; r < 4; ++r) { const float x = sx[st][r] * 0.125f; sx[st][r] = x;
                    const float sp = fmaxf(x, 0.f) + __logf(1.f + __expf(-fabsf(x)));
                    const float v = (16 * st + 4 * fq + r < lim) ? -sp : 0.f; lk[st][r] = v; tot += v; }
            bf16x8 hi[2], lo[2];
#pragma unroll
            for (int u = 0; u < 2; ++u) { u32x4 ph, pl; float rs[8];
#pragma unroll
                for (int r = 0; r < 4; ++r) { rs[r] = lk[2 * u][r]; rs[4 + r] = lk[2 * u + 1][r]; }
                ph.x = cvt_pk_bf16(rs[0], rs[1]); ph.y = cvt_pk_bf16(rs[2], rs[3]); ph.z = cvt_pk_bf16(rs[4], rs[5]); ph.w = cvt_pk_bf16(rs[6], rs[7]);
                pl.x = cvt_pk_bf16(rs[0] - bf_lo(ph.x), rs[1] - bf_hi(ph.x)); pl.y = cvt_pk_bf16(rs[2] - bf_lo(ph.y), rs[3] - bf_hi(ph.y));
                pl.z = cvt_pk_bf16(rs[4] - bf_lo(ph.z), rs[5] - bf_hi(ph.z)); pl.w = cvt_pk_bf16(rs[6] - bf_lo(ph.w), rs[7] - bf_hi(ph.w));
                hi[u] = __builtin_bit_cast(bf16x8, ph); lo[u] = __builtin_bit_cast(bf16x8, pl); }
            f32x4 suf[4];
            suf[0] = __builtin_amdgcn_mfma_f32_16x16x32_bf16(Ua, hi[0], z4, 0, 0, 0); suf[0] = __builtin_amdgcn_mfma_f32_16x16x32_bf16(Ua, lo[0], suf[0], 0, 0, 0);
            suf[0] = __builtin_amdgcn_mfma_f32_16x16x32_bf16(Uones, hi[1], suf[0], 0, 0, 0); suf[0] = __builtin_amdgcn_mfma_f32_16x16x32_bf16(Uones, lo[1], suf[0], 0, 0, 0);
            suf[1] = __builtin_amdgcn_mfma_f32_16x16x32_bf16(Ub, hi[0], z4, 0, 0, 0); suf[1] = __builtin_amdgcn_mfma_f32_16x16x32_bf16(Ub, lo[0], suf[1], 0, 0, 0);
            suf[1] = __builtin_amdgcn_mfma_f32_16x16x32_bf16(Uones, hi[1], suf[1], 0, 0, 0); suf[1] = __builtin_amdgcn_mfma_f32_16x16x32_bf16(Uones, lo[1], suf[1], 0, 0, 0);
            suf[2] = __builtin_amdgcn_mfma_f32_16x16x32_bf16(Ua, hi[1], z4, 0, 0, 0); suf[2] = __builtin_amdgcn_mfma_f32_16x16x32_bf16(Ua, lo[1], suf[2], 0, 0, 0);
            suf[3] = __builtin_amdgcn_mfma_f32_16x16x32_bf16(Ub, hi[1], z4, 0, 0, 0); suf[3] = __builtin_amdgcn_mfma_f32_16x16x32_bf16(Ub, lo[1], suf[3], 0, 0, 0);
            tot += __shfl_xor(tot, 16); tot += __shfl_xor(tot, 32);
            bf16x8 wf[2];
#pragma unroll
            for (int u = 0; u < 2; ++u) { float wv[8];
#pragma unroll
                for (int r = 0; r < 4; ++r) {
                    wv[r] = (16 * (2 * u) + 4 * fq + r < lim) ? __expf(sx[2 * u][r] + suf[2 * u][r] + carry[qt]) : 0.f;
                    wv[4 + r] = (16 * (2 * u + 1) + 4 * fq + r < lim) ? __expf(sx[2 * u + 1][r] + suf[2 * u + 1][r] + carry[qt]) : 0.f; }
                u32x4 pw; pw.x = cvt_pk_bf16(wv[0], wv[1]); pw.y = cvt_pk_bf16(wv[2], wv[3]); pw.z = cvt_pk_bf16(wv[4], wv[5]); pw.w = cvt_pk_bf16(wv[6], wv[7]);
                wf[u] = __builtin_bit_cast(bf16x8, pw); }
#pragma unroll
            for (int u = 0; u < 2; ++u) { u32x2 rr[8]; const unsigned ad = vrd + 32 * u * VT_STRIDE; tr_read8(ad, ad + 16 * VT_STRIDE, rr);
#pragma unroll
                for (int dt = 0; dt < 4; ++dt) o[dt][qt] = __builtin_amdgcn_mfma_f32_16x16x32_bf16(mk_frag(rr[2 * dt], rr[2 * dt + 1]), wf[u], o[dt][qt], 0, 0, 0); }
            carry[qt] += tot;
        }
        const float cm = fmaxf(carry[0], carry[1]);
        if (__all(cm < -104.f)) break;
    }
#pragma unroll
    for (int qt = 0; qt < 2; ++qt)
#pragma unroll
        for (int dt = 0; dt < 4; ++dt) { u32x2 w; w.x = cvt_pk_bf16(o[dt][qt].x, o[dt][qt].y); w.y = cvt_pk_bf16(o[dt][qt].z, o[dt][qt].w);
            *(u32x2*)(MIX + (size_t)(t0 + 16 * qt + fr) * D + h * HD + 16 * dt + 4 * fq) = w; }
}

__device__ __forceinline__ void p2_mix(const Frame& F, const Args& a, int qoff = 0) {
    unsigned* ctl = (unsigned*)(a.ws + WS_CTL) + qoff;
    for (int u = F.vcu; u < NCH * 2; u += F.G) ssd_a_unit(F, a, u >> 1, u & 1);
    for (;;) {
        int u = 0; if (F.lane == 0) u = (int)__hip_atomic_fetch_add(ctl + CW_ATTQ, 1u, RLX_AGENT);
        u = __builtin_amdgcn_readfirstlane(u);
        if (u >= H * (S / 32)) break;
        const int blk = (S / 32 - 1) - (u / H), h = u % H;
        attn_unit(F, a, h, blk * 32);
    }
}

typedef float f32x16 __attribute__((ext_vector_type(16)));
__device__ __forceinline__ void p6_router(const Frame& F, const Args& a) {
    const float* X2 = (const float*)(a.ws + WS_X2); unsigned char* H2 = (unsigned char*)(a.ws + WS_H2); const float* g_ffn = a.in[10]; const float* wr = a.in[11]; const float* br = a.in[12];
    unsigned* cnt = (unsigned*)(a.ws + WS_CTL) + CW_CNT; int* tokof = (int*)(a.ws + WS_TOKOF); int* TE = (int*)(a.ws + WS_TE); int* TP = (int*)(a.ws + WS_TP); float* TG = (float*)(a.ws + WS_TG);
    const int lane = fresh_lane(), w = F.wave;
    LAS float* part = (LAS float*)F.lds;
    LAS float* rs = (LAS float*)(F.lds + 32768);
    LAS float* lg = (LAS float*)(F.lds + 32768 + 128);
    for (int rb = F.vcu; rb < S / 32; rb += F.G) {
        const int row0 = rb * 32;
#pragma unroll 1
        for (int rr = 0; rr < 4; ++rr) { const int t = row0 + 4 * w + rr;
            f32x4 v[8]; const float r = rms_load(X2 + (size_t)t * D, lane, v);
            const f32x4* gp = (const f32x4*)g_ffn + lane; unsigned* o4 = (unsigned*)(H2 + (size_t)t * D) + lane;
#pragma unroll
            for (int j = 0; j < 8; ++j) { const f32x4 g = gp[64 * j]; o4[64 * j] = pg8::pk4_fp8(v[j].x * r * g.x, v[j].y * r * g.y, v[j].z * r * g.z, v[j].w * r * g.w); }
            if (lane == 0) rs[4 * w + rr] = r; }
        f32x16 acc;
#pragma unroll
        for (int i = 0; i < 16; ++i) acc[i] = 0.f;
        const int i32 = lane & 31, hh = lane >> 5;
        const float* xp = X2 + (size_t)(row0 + i32) * D + 256 * w + 4 * hh; const float* gq = g_ffn + 256 * w + 4 * hh; const float* wp = wr + (size_t)(256 * w + 4 * hh) * NE + i32;
#pragma unroll 4
        for (int kk = 0; kk < 32; ++kk) { const f32x4 xv = *(const f32x4*)(xp + 8 * kk), gv = *(const f32x4*)(gq + 8 * kk);
            const float b0 = wp[(size_t)(8 * kk + 0) * NE], b1 = wp[(size_t)(8 * kk + 1) * NE], b2 = wp[(size_t)(8 * kk + 2) * NE], b3 = wp[(size_t)(8 * kk + 3) * NE];
            acc = __builtin_amdgcn_mfma_f32_32x32x2f32(xv.x * gv.x, b0, acc, 0, 0, 0); acc = __builtin_amdgcn_mfma_f32_32x32x2f32(xv.y * gv.y, b1, acc, 0, 0, 0);
            acc = __builtin_amdgcn_mfma_f32_32x32x2f32(xv.z * gv.z, b2, acc, 0, 0, 0); acc = __builtin_amdgcn_mfma_f32_32x32x2f32(xv.w * gv.w, b3, acc, 0, 0, 0); }
#pragma unroll
        for (int r = 0; r < 16; ++r) part[(w * 32 + ((r & 3) + 8 * (r >> 2) + 4 * hh)) * 32 + i32] = acc[r];
        __syncthreads();
        for (int q = F.tid; q < 1024; q += NT) { const int i = q >> 5, e = q & 31; float sacc = 0.f;
#pragma unroll
            for (int ww = 0; ww < 8; ++ww) sacc += part[(ww * 32 + i) * 32 + e];
            lg[i * 33 + e] = sacc * rs[i] + br[e]; }
        __syncthreads();
        if (F.tid < 32) { const int t = row0 + F.tid; LAS float* L = lg + F.tid * 33;
            int sel[4]; float sv[4];
#pragma unroll
            for (int k = 0; k < 4; ++k) { float bv = -3.4e38f; int bi = 0;
                for (int e = 0; e < 32; ++e) { const float x = L[e]; if (x > bv) { bv = x; bi = e; } }
                L[bi] = -3.4e38f; sel[k] = bi; sv[k] = bv; }
            const float e1 = expf(sv[1] - sv[0]), e2 = expf(sv[2] - sv[0]), e3 = expf(sv[3] - sv[0]); const float inv = 1.f / (1.f + e1 + e2 + e3);
            const float gg[4] = {inv, e1 * inv, e2 * inv, e3 * inv};
#pragma unroll
            for (int k = 0; k < 4; ++k) { const int pos = (int)__hip_atomic_fetch_add(cnt + sel[k], 1u, RLX_AGENT);
                tokof[sel[k] * ECAP + pos] = t; TE[t * 4 + k] = sel[k]; TP[t * 4 + k] = pos; TG[t * 4 + k] = gg[k]; } }
        __syncthreads();
    }
}

__device__ __forceinline__ void moe_tables(const Frame& F, const Args& a, int ntn) {
    LAS int* T = (LAS int*)(F.lds + LDSCTL_OFF);
    unsigned* cnt = (unsigned*)(a.ws + WS_CTL) + CW_CNT;
    __syncthreads();
    if (F.tid == 0) { int pu = 0, po = 0;
        for (int e = 0; e < NE; ++e) { const int c = (int)__hip_atomic_load(cnt + e, RLX_AGENT); const int mt = (c + 255) >> 8; T[L_CNT + e] = c; T[L_PFXU + e] = pu; T[L_POFF + e] = po; pu += mt * ntn; po += mt * 256; }
        T[L_PFXU + NE] = pu; T[L_POFF + NE] = po; }
    __syncthreads();
}

__device__ __forceinline__ void p9_final(const Frame& F, const Args& a) {
    const float* X2 = (const float*)(a.ws + WS_X2); const bf16_t* YS = (const bf16_t*)(a.ws + WS_YS); const int* TE = (const int*)(a.ws + WS_TE); const int* TP = (const int*)(a.ws + WS_TP); const float* TG = (const float*)(a.ws + WS_TG);
    const float* g_final = a.in[17]; const LAS int* T = (const LAS int*)(F.lds + LDSCTL_OFF);
    const int gw = F.vcu * NWAVES + F.wave, NGW = F.G * NWAVES;
    for (int t = gw; t < S; t += NGW) {
        f32x4 v[8]; const f32x4* xr = (const f32x4*)(X2 + (size_t)t * D) + F.lane;
#pragma unroll
        for (int j = 0; j < 8; ++j) v[j] = xr[64 * j];
#pragma unroll
        for (int k = 0; k < 4; ++k) { const int e = TE[t * 4 + k], pos = TP[t * 4 + k]; const float g = TG[t * 4 + k];
            const u32x2* yp = (const u32x2*)(YS + (size_t)(T[L_POFF + e] + pos) * D) + F.lane;
#pragma unroll
            for (int j = 0; j < 8; ++j) { const u32x2 y = yp[64 * j]; v[j].x = fmaf(g, bf_lo(y.x), v[j].x); v[j].y = fmaf(g, bf_hi(y.x), v[j].y); v[j].z = fmaf(g, bf_lo(y.y), v[j].z); v[j].w = fmaf(g, bf_hi(y.y), v[j].w); } }
        float s = 0.f;
#pragma unroll
        for (int j = 0; j < 8; ++j) s += (v[j].x * v[j].x + v[j].y * v[j].y) + (v[j].z * v[j].z + v[j].w * v[j].w);
        const float r = rsqrtf(wave_sum(s) * (1.f / D) + EPS);
        const f32x4* gp = (const f32x4*)g_final + F.lane; f32x4* op = (f32x4*)(a.out + (size_t)t * D) + F.lane;
#pragma unroll
        for (int j = 0; j < 8; ++j) { const f32x4 g = gp[64 * j]; f32x4 o; o.x = v[j].x * r * g.x; o.y = v[j].y * r * g.y; o.z = v[j].z * r * g.z; o.w = v[j].w * r * g.w; op[64 * j] = o; }
    }
}

constexpr int NPHASE = 10;
__global__ void __launch_bounds__(NT, 2) mk_fwd(Args args) {
    extern __shared__ __attribute__((aligned(16))) unsigned char lds_raw[];
    Frame F; F.lds = (LAS unsigned char*)lds_raw; F.tid = threadIdx.x; F.lane = F.tid & 63; F.wave = __builtin_amdgcn_readfirstlane(F.tid >> 6);
    F.G = gridDim.x; { const int bx = blockIdx.x; F.vcu = (F.G % 8 == 0) ? (bx % 8) * (F.G / 8) + bx / 8 : bx; }
    unsigned char* ws = args.ws;
    for (int u = F.tid; u < (LDS_BYTES - LDSCTL_OFF) / 4; u += NT) ((LAS unsigned*)(F.lds + LDSCTL_OFF))[u] = 0u;
    __syncthreads();
    XcdBarrier bar; bar.bar = (unsigned*)(ws + WS_CTL) + CW_BAR; bar.x = 0; bar.st = nullptr;
    if (!MK_SPLIT) bar = xcd_barrier_post((unsigned*)(ws + WS_CTL) + CW_BAR, (volatile LAS unsigned*)(F.lds + LDSCTL_OFF) + L_MISC + 8);
    const int lo = args.ph_lo, hi = args.ph_hi;
#define IN(k) (lo <= (k) && (k) < hi)
#define SEAM(k) do { if (IN(k) && IN((k) + 1)) xcd_barrier(bar); } while (0)
    const LAS int* T = (const LAS int*)(F.lds + LDSCTL_OFF);
    if (IN(0)) { p0_prologue(F, args); if (PROBE_REP & 1) { xcd_barrier(bar); p0_prologue(F, args); } } SEAM(0);
    if (IN(1)) { pg8::NatOrder So; So.init(ws + WS_XN, ws + WS_WIN, S, NPAD, F.G, (int)blockIdx.x); pg8::EpiProj E{(bf16_t*)(ws + WS_PROJ), (float*)(ws + WS_DT)};
        pg8::gemm_phase<pg8::EpiProj, pg8::NatOrder>(F.lds, So, E); if (PROBE_REP & 2) { xcd_barrier(bar); pg8::gemm_phase<pg8::EpiProj, pg8::NatOrder>(F.lds, So, E); } } SEAM(1);
    if (IN(2)) { p2_mix(F, args); if (PROBE_REP & 4) { xcd_barrier(bar); p2_mix(F, args, 64); } } SEAM(2);
    if (IN(3)) { ssd_scan(F, args); if (PROBE_REP & 8) { xcd_barrier(bar); ssd_scan(F, args); } } SEAM(3);
    if (IN(4)) { for (int u = F.vcu; u < NCH * 2; u += F.G) ssd_c_unit(F, args, u >> 1, u & 1); if (PROBE_REP & 16) { xcd_barrier(bar); for (int u = F.vcu; u < NCH * 2; u += F.G) ssd_c_unit(F, args, u >> 1, u & 1); } } SEAM(4);
    if (IN(5)) { pg8::NatOrder So; So.init(ws + WS_MIX, ws + WS_WOUT, S, D, F.G, (int)blockIdx.x); pg8::EpiRes E{args.in[0], (float*)(ws + WS_X2)};
        pg8::gemm_phase<pg8::EpiRes, pg8::NatOrder>(F.lds, So, E); } SEAM(5);
    if (IN(6)) { p6_router(F, args); } SEAM(6);
    if (IN(7)) { moe_tables(F, args, 16);
        pg8::MoeOrder<true> So{(const char*)(ws + WS_H2), (const char*)(ws + WS_WGU), (const int*)(ws + WS_TOKOF), T + L_CNT, T + L_PFXU, T + L_POFF, 16, F.G, F.vcu};
        pg8::EpiGU E{(unsigned char*)(ws + WS_ACT), args.in[14], T + L_POFF};
        pg8::gemm_phase<pg8::EpiGU, pg8::MoeOrder<true>>(F.lds, So, E); if (PROBE_REP & 128) { xcd_barrier(bar); pg8::gemm_phase<pg8::EpiGU, pg8::MoeOrder<true>>(F.lds, So, E); } } SEAM(7);
    if (IN(8)) { moe_tables(F, args, 8);
        pg8::MoeOrder<false> So{(const char*)(ws + WS_ACT), (const char*)(ws + WS_WDN), nullptr, T + L_CNT, T + L_PFXU, T + L_POFF, 8, F.G, F.vcu};
        pg8::EpiDown E{(bf16_t*)(ws + WS_YS), args.in[16], T + L_POFF};
        pg8::gemm_phase<pg8::EpiDown, pg8::MoeOrder<false>>(F.lds, So, E); if (PROBE_REP & 256) { xcd_barrier(bar); pg8::gemm_phase<pg8::EpiDown, pg8::MoeOrder<false>>(F.lds, So, E); } } SEAM(8);
    if (IN(9)) { moe_tables(F, args, 8); p9_final(F, args); if (PROBE_REP & 512) { xcd_barrier(bar); p9_final(F, args); } }
#undef IN
#undef SEAM
}

extern "C" void kernel_launch(void* const* d_in, const int* in_sizes, int n_in, void* d_out, int out_size, void* d_ws, size_t ws_size, hipStream_t stream) {
    static int grid = 0;
    if (grid == 0) {
        if (n_in != 18 || out_size != S * D || ws_size < WS_END) { fprintf(stderr, "kernel_launch: unexpected problem (n_in %d out %d ws %zu need %zu)\n", n_in, out_size, ws_size, (size_t)WS_END); grid = -1; return; }
        int dev = 0, cus = 0, per_cu = 0;
        if (hipGetDevice(&dev) != hipSuccess || hipDeviceGetAttribute(&cus, hipDeviceAttributeMultiprocessorCount, dev) != hipSuccess) { grid = -1; return; }
        if (hipFuncSetAttribute((const void*)mk_fwd, hipFuncAttributeMaxDynamicSharedMemorySize, LDS_BYTES) != hipSuccess) { fprintf(stderr, "kernel_launch: hipFuncSetAttribute failed\n"); grid = -1; return; }
        if (hipOccupancyMaxActiveBlocksPerMultiprocessor(&per_cu, (const void*)mk_fwd, NT, LDS_BYTES) != hipSuccess || per_cu < 1) { fprintf(stderr, "kernel_launch: occupancy query says %d\n", per_cu); }
        (void)hipGetLastError();
        grid = cus;
    }
    if (grid < 0) return;
    if (hipMemsetAsync((char*)d_ws + WS_CTL, 0, CTL_ZERO_BYTES, stream) != hipSuccess) return;
    Args a; memset(&a, 0, sizeof a);
    for (int i = 0; i < 18; ++i) a.in[i] = (const float*)d_in[i];
    a.out = (float*)d_out; a.ws = (unsigned char*)d_ws;
#if MK_SPLIT
    for (int p = 0; p < NPHASE; ++p) { a.ph_lo = p; a.ph_hi = p + 1; hipLaunchKernelGGL(mk_fwd, dim3(grid), dim3(NT), LDS_BYTES, stream, a); }
#else
    a.ph_lo = 0; a.ph_hi = NPHASE; hipLaunchKernelGGL(mk_fwd, dim3(grid), dim3(NT), LDS_BYTES, stream, a);
#endif
}
```
